# Optimizing an MI355X kernel written in HIP

```python
import math
import jax, jax.numpy as jnp
from jax import lax
import numpy as np

D_MODEL = 1024
BATCH = 4
SEQ = 4096
DEPTH = 2

D_MIX = D_MODEL
HEAD_DIM = 64
D_ATT = D_MIX // 2
D_LRU = D_MIX // 4
D_SG = D_MIX - D_ATT - D_LRU
N_ATT_HEADS = D_ATT // HEAD_DIM
N_LRU_BLOCKS = D_LRU // HEAD_DIM
N_SG_GROUPS = D_SG // HEAD_DIM
Q_BLOCK = 128
SG_CHUNK = 128
CONV_WIDTH = 4
LRU_C = 8.0
EPS = 1e-6
IN_SIZES = (D_ATT, D_ATT, D_ATT, N_ATT_HEADS, D_ATT, D_LRU, D_LRU, D_SG, D_SG, D_SG)
D_IN = 4 * D_ATT + N_ATT_HEADS + 2 * D_LRU + 3 * D_SG

kernel_name = "hybrid_fox_rglru_gmlp_parallel_heads"


def rms_norm(x, g):
    xf = x.astype(jnp.float32)
    y = xf * lax.rsqrt(jnp.mean(xf * xf, axis=-1, keepdims=True) + EPS)
    return (y * g.astype(jnp.float32)).astype(x.dtype)


def layer_norm(x, g, b):
    xf = x.astype(jnp.float32)
    mu = jnp.mean(xf, axis=-1, keepdims=True)
    var = jnp.mean(jnp.square(xf - mu), axis=-1, keepdims=True)
    y = (xf - mu) * lax.rsqrt(var + EPS)
    return (y * g.astype(jnp.float32) + b.astype(jnp.float32)).astype(x.dtype)


def forgetting_attention(q, k, v, f_logit):
    B, S, H, Dh = q.shape
    n_blk = S // Q_BLOCK
    scale = 1.0 / math.sqrt(Dh)
    F = jnp.cumsum(jax.nn.log_sigmoid(f_logit.astype(jnp.float32)), axis=1)
    F = F.transpose(0, 2, 1)
    kh = k.transpose(0, 2, 1, 3)
    vh = v.transpose(0, 2, 1, 3)
    qb = q.reshape(B, n_blk, Q_BLOCK, H, Dh).transpose(1, 0, 3, 2, 4)
    Fq = F.reshape(B, H, n_blk, Q_BLOCK).transpose(2, 0, 1, 3)
    key_pos = jnp.arange(S)
    neg = jnp.finfo(jnp.float32).min

    def block(args):
        q_i, Fq_i, i = args
        s = jnp.einsum('bhqd,bhkd->bhqk', q_i, kh).astype(jnp.float32) * scale
        s = s + Fq_i[..., None] - F[:, :, None, :]
        q_pos = i * Q_BLOCK + jnp.arange(Q_BLOCK)
        mask = key_pos[None, :] <= q_pos[:, None]
        p = jax.nn.softmax(jnp.where(mask, s, neg), axis=-1)
        return jnp.einsum('bhqk,bhkd->bhqd', p.astype(vh.dtype), vh)

    out = lax.map(block, (qb, Fq, jnp.arange(n_blk)))
    return out.transpose(1, 0, 3, 2, 4).reshape(B, S, H * Dh)


def causal_depthwise_conv(x, w, b):
    S = x.shape[1]
    xp = jnp.pad(x, ((0, 0), (CONV_WIDTH - 1, 0), (0, 0)))
    y = b
    for kk in range(CONV_WIDTH):
        y = y + xp[:, kk:kk + S, :] * w[kk]
    return y


def rg_lru(x, wa, ba, wx, bx, lam):
    B, S, C = x.shape
    xg = x.reshape(B, S, N_LRU_BLOCKS, C // N_LRU_BLOCKS)
    r = jax.nn.sigmoid((jnp.einsum('bsgi,gij->bsgj', xg, wa).reshape(B, S, C) + ba).astype(jnp.float32))
    i = jax.nn.sigmoid((jnp.einsum('bsgi,gij->bsgj', xg, wx).reshape(B, S, C) + bx).astype(jnp.float32))
    log_a = -LRU_C * r * jax.nn.softplus(-lam.astype(jnp.float32))
    a = jnp.exp(log_a)
    b_term = jnp.sqrt(-jnp.expm1(2.0 * log_a)) * (i * x.astype(jnp.float32))

    def combine(left, right):
        a1, b1 = left
        a2, b2 = right
        return a1 * a2, a2 * b1 + b2

    _, h = lax.associative_scan(combine, (a, b_term), axis=1)
    return h.astype(x.dtype)


def spatial_gate(u, v, ln_g, ln_b, w_s, b_s):
    B, S, C = u.shape
    n_chunk = S // SG_CHUNK
    vn = layer_norm(v, ln_g, ln_b).reshape(B, n_chunk, SG_CHUNK, N_SG_GROUPS, C // N_SG_GROUPS)
    tril = jnp.tril(jnp.ones((SG_CHUNK, SG_CHUNK), dtype=w_s.dtype))
    w = w_s * tril
    z = jnp.einsum('gts,bcsgd->bctgd', w, vn) + b_s.T[None, None, :, :, None]
    return u * z.reshape(B, S, C)


def hybrid_layer(x, c, ada_w, ada_b, pre_g, post_g, w_in, b_f, conv_w, conv_b,
                 lru_wa, lru_ba, lru_wx, lru_bx, lru_lambda,
                 sg_ln_g, sg_ln_b, sg_w, sg_b, w_out):
    B, S, _ = x.shape
    mod = jax.nn.silu(c) @ ada_w + ada_b
    shift, scale, gate = jnp.split(mod, 3, axis=-1)
    h = rms_norm(x, pre_g) * (1.0 + scale[:, None, :]) + shift[:, None, :]

    proj = h @ w_in
    cuts = np.cumsum(IN_SIZES)[:-1].tolist()
    (q, k, v, f_logit, g_att, x_lru, g_lru, sg_u, sg_v, g_sg) = jnp.split(proj, cuts, axis=-1)

    heads = lambda t: t.reshape(B, S, N_ATT_HEADS, HEAD_DIM)
    y_att = forgetting_attention(heads(q), heads(k), heads(v), f_logit + b_f)
    y_att = y_att * jax.nn.silu(g_att)

    x_c = causal_depthwise_conv(x_lru, conv_w, conv_b)
    y_lru = rg_lru(x_c, lru_wa, lru_ba, lru_wx, lru_bx, lru_lambda) * jax.nn.silu(g_lru)

    y_sg = spatial_gate(jax.nn.gelu(sg_u), jax.nn.gelu(sg_v), sg_ln_g, sg_ln_b, sg_w, sg_b)
    y_sg = y_sg * jax.nn.silu(g_sg)

    y = jnp.concatenate([y_att, y_lru, y_sg], axis=-1) @ w_out
    return x + gate[:, None, :] * rms_norm(y, post_g)


def setup_inputs(seed: int = 0) -> dict:
    key = jax.random.key(seed)
    ks = jax.random.split(key, 24)
    D, L = D_MODEL, DEPTH
    nrm = lambda k_, shape, s: jax.random.normal(k_, shape, jnp.float32) * s
    x = jax.random.normal(ks[0], (BATCH, SEQ, D), jnp.float32)
    c = jax.random.normal(ks[1], (BATCH, D), jnp.float32)
    ada_w = nrm(ks[2], (L, D, 3 * D), 0.5 * D ** -0.5)
    ada_b = nrm(ks[3], (L, 3 * D), 0.01)
    pre_g = 1.0 + nrm(ks[4], (L, D), 0.01)
    post_g = 1.0 + nrm(ks[5], (L, D), 0.01)
    w_in = nrm(ks[6], (L, D, D_IN), D ** -0.5)
    b_f = jax.random.uniform(ks[7], (L, N_ATT_HEADS), jnp.float32, 1.0, 4.0)
    conv_w = nrm(ks[8], (L, CONV_WIDTH, D_LRU), CONV_WIDTH ** -0.5)
    conv_b = nrm(ks[9], (L, D_LRU), 0.01)
    blk = D_LRU // N_LRU_BLOCKS
    lru_wa = nrm(ks[10], (L, N_LRU_BLOCKS, blk, blk), blk ** -0.5)
    lru_ba = nrm(ks[11], (L, D_LRU), 0.01)
    lru_wx = nrm(ks[12], (L, N_LRU_BLOCKS, blk, blk), blk ** -0.5)
    lru_bx = nrm(ks[13], (L, D_LRU), 0.01)
    a0 = jax.random.uniform(ks[14], (L, D_LRU), jnp.float32, 0.9, 0.999)
    a_base = a0 ** (1.0 / LRU_C)
    lru_lambda = jnp.log(a_base) - jnp.log1p(-a_base)
    sg_ln_g = 1.0 + nrm(ks[15], (L, D_SG), 0.01)
    sg_ln_b = nrm(ks[16], (L, D_SG), 0.01)
    sg_w = nrm(ks[17], (L, N_SG_GROUPS, SG_CHUNK, SG_CHUNK), SG_CHUNK ** -0.5)
    sg_b = 1.0 + nrm(ks[18], (L, N_SG_GROUPS, SG_CHUNK), 0.01)
    w_out = nrm(ks[19], (L, D_MIX, D), D_MIX ** -0.5)
    return {"x": x, "c": c, "ada_w": ada_w, "ada_b": ada_b, "pre_g": pre_g, "post_g": post_g,
            "w_in": w_in, "b_f": b_f, "conv_w": conv_w, "conv_b": conv_b,
            "lru_wa": lru_wa, "lru_ba": lru_ba, "lru_wx": lru_wx, "lru_bx": lru_bx,
            "lru_lambda": lru_lambda, "sg_ln_g": sg_ln_g, "sg_ln_b": sg_ln_b,
            "sg_w": sg_w, "sg_b": sg_b, "w_out": w_out}


def reference(x, c, ada_w, ada_b, pre_g, post_g, w_in, b_f, conv_w, conv_b,
              lru_wa, lru_ba, lru_wx, lru_bx, lru_lambda,
              sg_ln_g, sg_ln_b, sg_w, sg_b, w_out):
    for l in range(DEPTH):
        x = hybrid_layer(x, c, ada_w[l], ada_b[l], pre_g[l], post_g[l], w_in[l], b_f[l],
                         conv_w[l], conv_b[l], lru_wa[l], lru_ba[l], lru_wx[l], lru_bx[l],
                         lru_lambda[l], sg_ln_g[l], sg_ln_b[l], sg_w[l], sg_b[l], w_out[l])
    return x
```

```cpp
#include <hip/hip_runtime.h>
#include <hip/hip_cooperative_groups.h>
#include <cstdio>
#include <cstdint>
namespace cg = cooperative_groups;

typedef unsigned short bf16_t;
typedef short bf16x8 __attribute__((ext_vector_type(8)));
typedef float f32x16 __attribute__((ext_vector_type(16)));
typedef float f32x4 __attribute__((ext_vector_type(4)));

constexpr int NB = 4, SEQ = 4096, DM = 1024, MROWS = NB * SEQ, NLAYER = 2;
constexpr int DIN = 3336, NPROJ = 3328;
constexpr int FCOL = 1536;
constexpr int NTHREADS = 512;
constexpr float EPS = 1e-6f;
constexpr float LOG2E = 1.4426950408889634f;
constexpr float QSCALE = 0.125f * LOG2E;

constexpr size_t MiB = 1u << 20;
constexpr size_t WS_WINT = 2 * MiB;
constexpr size_t WS_WINT_STRIDE = 7 * MiB;
constexpr size_t WS_WOUTT = 16 * MiB;
constexpr size_t WS_MOD = 20 * MiB;
constexpr size_t WS_SGW = 21 * MiB;
constexpr size_t WS_WAT = 22 * MiB;
constexpr size_t WS_LS = 23 * MiB;
constexpr size_t WS_FC = 24 * MiB;
constexpr size_t WS_AGG = 25 * MiB;
constexpr size_t WS_H = 32 * MiB;
constexpr size_t WS_Q = 64 * MiB, WS_K = 80 * MiB, WS_V = 96 * MiB, WS_GATT = 112 * MiB;
constexpr size_t WS_XLRU = 128 * MiB, WS_GLRU = 136 * MiB, WS_SGU = 144 * MiB, WS_SGV = 152 * MiB, WS_GSG = 160 * MiB;
constexpr size_t WS_Y = 168 * MiB;
constexpr size_t WS_YOUT = 64 * MiB;
constexpr size_t WS_END = 200 * MiB;

constexpr int LDS_BYTES = 147456;

struct Params {
    const float *x, *c, *ada_w, *ada_b, *pre_g, *post_g, *w_in, *b_f, *conv_w, *conv_b, *lru_wa, *lru_ba, *lru_wx, *lru_bx, *lru_lambda,
        *sg_ln_g, *sg_ln_b, *sg_w, *sg_b, *w_out;
    float* out; unsigned char* ws;
};

__device__ __forceinline__ unsigned f2bf(float f) { unsigned u = __float_as_uint(f); return (u + 0x7fffu + ((u >> 16) & 1u)) >> 16; }
__device__ __forceinline__ unsigned pk2(float lo, float hi) { return f2bf(lo) | (f2bf(hi) << 16); }
__device__ __forceinline__ float bf2f(unsigned h) { return __uint_as_float(h << 16); }
__device__ __forceinline__ float bflo(unsigned w) { return __uint_as_float(w << 16); }
__device__ __forceinline__ float bfhi(unsigned w) { return __uint_as_float(w & 0xffff0000u); }
__device__ __forceinline__ float wave_sum(float v) {
#pragma unroll
    for (int o = 1; o < 64; o <<= 1) v += __shfl_xor(v, o);
    return v;
}
__device__ __forceinline__ float sigmoid_f(float v) { return 1.f / (1.f + __expf(-v)); }
__device__ __forceinline__ float silu_f(float v) { return v / (1.f + __expf(-v)); }
__device__ __forceinline__ float gelu_f(float v) { const float u = 1.5957691216057308f * (v + 0.044715f * v * v * v); return v / (1.f + __expf(-u)); }
__device__ __forceinline__ int crow(int r, int hi) { return (r & 3) + 8 * (r >> 2) + 4 * hi; }

struct ProjOut { bf16_t *Q, *K, *V, *GATT, *XLRU, *GLRU, *SGU, *SGV, *GSG; };
__device__ __forceinline__ void proj_store(const ProjOut& P, int row, int n, float v) {
    if (n < 512) P.Q[(size_t)row * 512 + n] = (bf16_t)f2bf(v * QSCALE);
    else if (n < 1024) P.K[(size_t)row * 512 + n - 512] = (bf16_t)f2bf(v);
    else if (n < 1536) P.V[(size_t)row * 512 + n - 1024] = (bf16_t)f2bf(v);
    else if (n < 2048) P.GATT[(size_t)row * 512 + n - 1536] = (bf16_t)f2bf(silu_f(v));
    else if (n < 2304) P.XLRU[(size_t)row * 256 + n - 2048] = (bf16_t)f2bf(v);
    else if (n < 2560) P.GLRU[(size_t)row * 256 + n - 2304] = (bf16_t)f2bf(silu_f(v));
    else if (n < 2816) P.SGU[(size_t)row * 256 + n - 2560] = (bf16_t)f2bf(gelu_f(v));
    else if (n < 3072) P.SGV[(size_t)row * 256 + n - 2816] = (bf16_t)f2bf(gelu_f(v));
    else P.GSG[(size_t)row * 256 + n - 3072] = (bf16_t)f2bf(silu_f(v));
}

__device__ __forceinline__ void p0_mod_item(int item, const Params& p, float* MOD, float* lds) {
    int tid = threadIdx.x; asm volatile("" : "+v"(tid));
    const int l = item / 48, n0 = (item % 48) * 64;
    float* sc = lds;
    float* red = lds + 4096;
    for (int i = tid; i < 4096; i += NTHREADS) sc[i] = silu_f(p.c[i]);
    __syncthreads();
    const int nl = tid & 63, ks = tid >> 6;
    float a0 = 0.f, a1 = 0.f, a2 = 0.f, a3 = 0.f;
    const float* w = p.ada_w + ((size_t)l * 1024 + ks * 128) * 3072 + n0 + nl;
#pragma unroll 8
    for (int k = 0; k < 128; ++k) {
        const float wv = w[(size_t)k * 3072]; const int kk = ks * 128 + k;
        a0 += sc[kk] * wv; a1 += sc[1024 + kk] * wv; a2 += sc[2048 + kk] * wv; a3 += sc[3072 + kk] * wv;
    }
    red[(ks * 4 + 0) * 64 + nl] = a0; red[(ks * 4 + 1) * 64 + nl] = a1; red[(ks * 4 + 2) * 64 + nl] = a2; red[(ks * 4 + 3) * 64 + nl] = a3;
    __syncthreads();
    if (tid < 256) {
        const int b = tid >> 6; float s = p.ada_b[l * 3072 + n0 + nl];
#pragma unroll
        for (int k = 0; k < 8; ++k) s += red[(k * 4 + b) * 64 + nl];
        MOD[(size_t)(l * 4 + b) * 3072 + n0 + nl] = s;
    }
    __syncthreads();
}
__device__ __forceinline__ void p0_tr_item(const float* W, int ldn, int k0, int csrc0, bf16_t* WT, int n0, float* tile) {
    int tid = threadIdx.x; asm volatile("" : "+v"(tid));
    {
        const int r = tid >> 6, cc = tid & 63;
#pragma unroll
        for (int i = 0; i < 8; ++i) { const int k = r + 8 * i; tile[k * 65 + cc] = W[(size_t)(k0 + k) * ldn + csrc0 + cc]; }
    }
    __syncthreads();
    {
        const int n = tid >> 3, kc = tid & 7;
        const float* s = tile + (kc * 8) * 65 + n;
        uint4 o; o.x = pk2(s[0], s[65]); o.y = pk2(s[2 * 65], s[3 * 65]); o.z = pk2(s[4 * 65], s[5 * 65]); o.w = pk2(s[6 * 65], s[7 * 65]);
        *(uint4*)(WT + (size_t)(n0 + n) * 1024 + k0 + kc * 8) = o;
    }
    __syncthreads();
}
__device__ __forceinline__ void p0_prologue(const Params& p, float* lds) {
    unsigned char* ws = p.ws;
    float* MOD = (float*)(ws + WS_MOD);
    const int G = gridDim.x, blk = blockIdx.x; int tid = threadIdx.x; asm volatile("" : "+v"(tid));
    constexpr int N_MOD = 96, N_WIN = 2 * 16 * 52, N_WOUT = 2 * 16 * 16;
    for (int it = blk; it < N_MOD + N_WIN + N_WOUT; it += G) {
        if (it < N_MOD) { p0_mod_item(it, p, MOD, lds); continue; }
        int r = it - N_MOD;
        if (r < N_WIN) {
            const int l = r / (16 * 52), q = r % (16 * 52), kb = q / 52, nb = q % 52;
            const int n0 = nb * 64, csrc0 = n0 + (n0 >= FCOL ? 8 : 0);
            p0_tr_item(p.w_in + (size_t)l * 1024 * DIN, DIN, kb * 64, csrc0, (bf16_t*)(ws + WS_WINT + l * WS_WINT_STRIDE), n0, lds);
            continue;
        }
        r -= N_WIN;
        { const int l = r / 256, q = r % 256, kb = q / 16, nb = q % 16;
          p0_tr_item(p.w_out + (size_t)l * 1024 * 1024, 1024, kb * 64, nb * 64, (bf16_t*)(ws + WS_WOUTT + (size_t)l * 2 * MiB), nb * 64, lds); }
    }
    const int gt = blk * NTHREADS + tid, GT = G * NTHREADS;
    bf16_t* SGW = (bf16_t*)(ws + WS_SGW);
    for (int i = gt; i < 2 * 4 * 128 * 128; i += GT) { const int s = i & 127, t = (i >> 7) & 127; SGW[i] = (bf16_t)(s <= t ? f2bf(p.sg_w[i]) : 0u); }
    bf16_t* WAT = (bf16_t*)(ws + WS_WAT);
    for (int i = gt; i < 2 * 2 * 4 * 64 * 64; i += GT) {
        const int ii = i & 63, j = (i >> 6) & 63, g = (i >> 12) & 3, mat = (i >> 14) & 1, l = i >> 15;
        const float* src = mat ? p.lru_wx : p.lru_wa;
        WAT[i] = (bf16_t)f2bf(src[((size_t)(l * 4 + g) * 64 + ii) * 64 + j]);
    }
}

template <bool FIRST, bool NEXT>
__device__ __forceinline__ void row_pass(const Params& p, int lprev, int ln, const float* xres, float* xout, float* lds) {
    unsigned char* ws = p.ws;
    int tid = threadIdx.x; asm volatile("" : "+v"(tid)); const int lane = tid & 63, wave = tid >> 6;
    const float* MOD = (const float*)(ws + WS_MOD);
    const bf16_t* YOUT = (const bf16_t*)(ws + WS_YOUT);
    bf16_t* H = (bf16_t*)(ws + WS_H);
    float* LS = (float*)(ws + WS_LS);
    float* wfl = lds;
    if (NEXT) {
        for (int i = tid; i < 8192; i += NTHREADS) { const int cc = i >> 3, jj = i & 7; wfl[jj * 1024 + cc] = p.w_in[((size_t)ln * 1024 + cc) * DIN + FCOL + jj]; }
        __syncthreads();
    }
    const int gw = blockIdx.x * 8 + wave, NGW = gridDim.x * 8;
    for (int row = gw; row < MROWS; row += NGW) {
        const int b = row >> 12;
        f32x4 xv[4];
#pragma unroll
        for (int j = 0; j < 4; ++j) xv[j] = *(const f32x4*)(xres + (size_t)row * DM + j * 256 + lane * 4);
        if (!FIRST) {
            f32x4 yv[4]; float ss = 0.f;
#pragma unroll
            for (int j = 0; j < 4; ++j) {
                const uint2 w = *(const uint2*)(YOUT + (size_t)row * DM + j * 256 + lane * 4);
                yv[j] = (f32x4){bflo(w.x), bfhi(w.x), bflo(w.y), bfhi(w.y)};
                ss += (yv[j].x * yv[j].x + yv[j].y * yv[j].y) + (yv[j].z * yv[j].z + yv[j].w * yv[j].w);
            }
            const float rinv = rsqrtf(wave_sum(ss) * (1.f / DM) + EPS);
            const float* gate = MOD + (size_t)(lprev * 4 + b) * 3072 + 2048;
#pragma unroll
            for (int j = 0; j < 4; ++j) {
                const f32x4 pg = *(const f32x4*)(p.post_g + lprev * DM + j * 256 + lane * 4);
                const f32x4 gt = *(const f32x4*)(gate + j * 256 + lane * 4);
                xv[j] = xv[j] + gt * ((yv[j] * rinv) * pg);
                *(f32x4*)(xout + (size_t)row * DM + j * 256 + lane * 4) = xv[j];
            }
        }
        if (NEXT) {
            float ss = 0.f;
#pragma unroll
            for (int j = 0; j < 4; ++j) ss += (xv[j].x * xv[j].x + xv[j].y * xv[j].y) + (xv[j].z * xv[j].z + xv[j].w * xv[j].w);
            const float rinv = rsqrtf(wave_sum(ss) * (1.f / DM) + EPS);
            const float* shift = MOD + (size_t)(ln * 4 + b) * 3072;
            const float* scale = shift + 1024;
            float fl[8];
#pragma unroll
            for (int jj = 0; jj < 8; ++jj) fl[jj] = 0.f;
#pragma unroll
            for (int j = 0; j < 4; ++j) {
                const int c0 = j * 256 + lane * 4;
                const f32x4 pg = *(const f32x4*)(p.pre_g + ln * DM + c0);
                const f32x4 sh = *(const f32x4*)(shift + c0);
                const f32x4 sc = *(const f32x4*)(scale + c0);
                const f32x4 hv = ((xv[j] * rinv) * pg) * (sc + 1.0f) + sh;
                uint2 o; o.x = pk2(hv.x, hv.y); o.y = pk2(hv.z, hv.w);
                *(uint2*)(H + (size_t)row * DM + c0) = o;
#pragma unroll
                for (int jj = 0; jj < 8; ++jj) { const f32x4 wv = *(const f32x4*)(wfl + jj * 1024 + c0); fl[jj] += (hv.x * wv.x + hv.y * wv.y) + (hv.z * wv.z + hv.w * wv.w); }
                asm volatile("" ::: "memory");
            }
#pragma unroll
            for (int jj = 0; jj < 8; ++jj) fl[jj] = wave_sum(fl[jj]);
            float mine = fl[0];
#pragma unroll
            for (int jj = 1; jj < 8; ++jj) mine = (lane == jj) ? fl[jj] : mine;
            if (lane < 8) {
                const float z = mine + p.b_f[ln * 8 + lane];
                const float lsg = fminf(z, 0.f) - log1pf(__expf(-fabsf(z)));
                LS[(size_t)row * 8 + lane] = lsg * LOG2E;
            }
        }
    }
    __syncthreads();
}

template <class Store>
__device__ __forceinline__ void gemm_naive(const bf16_t* A, const bf16_t* Bt, int N, float* lds, const Store& st) {
    float* As = lds; float* Bs = lds + 32 * 68;
    int tid = threadIdx.x; asm volatile("" : "+v"(tid)); const int ntn = N / 64, ntiles = (MROWS / 64) * ntn;
    const int r = tid >> 3, kq = tid & 7, ty = tid >> 4, tx = tid & 15;
    for (int tile = blockIdx.x; tile < ntiles; tile += gridDim.x) {
        const int tm = tile / ntn, tn = tile % ntn;
        float acc[2][4];
#pragma unroll
        for (int i = 0; i < 2; ++i)
#pragma unroll
            for (int j = 0; j < 4; ++j) acc[i][j] = 0.f;
        for (int k0 = 0; k0 < 1024; k0 += 32) {
            const uint2 av = *(const uint2*)(A + (size_t)(tm * 64 + r) * 1024 + k0 + kq * 4);
            const uint2 bv = *(const uint2*)(Bt + (size_t)(tn * 64 + r) * 1024 + k0 + kq * 4);
            As[(kq * 4 + 0) * 68 + r] = bflo(av.x); As[(kq * 4 + 1) * 68 + r] = bfhi(av.x); As[(kq * 4 + 2) * 68 + r] = bflo(av.y); As[(kq * 4 + 3) * 68 + r] = bfhi(av.y);
            Bs[(kq * 4 + 0) * 68 + r] = bflo(bv.x); Bs[(kq * 4 + 1) * 68 + r] = bfhi(bv.x); Bs[(kq * 4 + 2) * 68 + r] = bflo(bv.y); Bs[(kq * 4 + 3) * 68 + r] = bfhi(bv.y);
            __syncthreads();
#pragma unroll 8
            for (int k = 0; k < 32; ++k) {
                const float2 a = *(const float2*)&As[k * 68 + ty * 2];
                const float4 bq = *(const float4*)&Bs[k * 68 + tx * 4];
                acc[0][0] += a.x * bq.x; acc[0][1] += a.x * bq.y; acc[0][2] += a.x * bq.z; acc[0][3] += a.x * bq.w;
                acc[1][0] += a.y * bq.x; acc[1][1] += a.y * bq.y; acc[1][2] += a.y * bq.z; acc[1][3] += a.y * bq.w;
            }
            __syncthreads();
        }
#pragma unroll
        for (int i = 0; i < 2; ++i)
#pragma unroll
            for (int j = 0; j < 4; ++j) st(tm * 64 + ty * 2 + i, tn * 64 + tx * 4 + j, acc[i][j]);
    }
}
struct StoreProj { ProjOut P; __device__ __forceinline__ void operator()(int row, int n, float v) const { proj_store(P, row, n, v); } };
struct StoreBf16 { bf16_t* O; int ld; __device__ __forceinline__ void operator()(int row, int n, float v) const { O[(size_t)row * ld + n] = (bf16_t)f2bf(v); } };

__device__ __forceinline__ void fcum_item(int bh, const float* LS, float* FC, float* lds) {
    int tid = threadIdx.x; asm volatile("" : "+v"(tid)); const int b = bh >> 3, h = bh & 7;
    float v[8]; float run = 0.f;
#pragma unroll
    for (int i = 0; i < 8; ++i) { run += LS[((size_t)b * SEQ + tid * 8 + i) * 8 + h]; v[i] = run; }
    float* s0 = lds; float* s1 = lds + 512;
    s0[tid] = run;
    __syncthreads();
    float* src = s0; float* dst = s1;
    for (int off = 1; off < 512; off <<= 1) {
        float t = src[tid]; if (tid >= off) t += src[tid - off];
        dst[tid] = t;
        __syncthreads();
        float* tmp = src; src = dst; dst = tmp;
    }
    const float excl = src[tid] - run;
#pragma unroll
    for (int i = 0; i < 8; ++i) FC[(size_t)bh * SEQ + tid * 8 + i] = v[i] + excl;
    __syncthreads();
}

template <int MODE>
__device__ __forceinline__ void lru_item(int item, int layer, const Params& p, unsigned char* ldsb) {
    unsigned char* ws = p.ws;
    int tid = threadIdx.x; asm volatile("" : "+v"(tid)); const int lane = tid & 63, wave = tid >> 6;
    const int b = item >> 7, c = item & 127, t0 = c * 32; const size_t r0 = (size_t)b * SEQ + t0;
    const bf16_t* XLRU = (const bf16_t*)(ws + WS_XLRU);
    const bf16_t* GLRU = (const bf16_t*)(ws + WS_GLRU);
    const bf16_t* WAT = (const bf16_t*)(ws + WS_WAT);
    float* AGG = (float*)(ws + WS_AGG);
    bf16_t* Y = (bf16_t*)(ws + WS_Y);
    bf16_t* xcb = (bf16_t*)ldsb;
    float* aL = (float*)(ldsb + 32 * 264 * 2);
    float* bL = aL + 32 * 256;
    float* ex = bL + 32 * 256;
    {
        const int ch = (tid & 127) * 2, tq = tid >> 7;
        float w0[4], w1[4];
#pragma unroll
        for (int k = 0; k < 4; ++k) { w0[k] = p.conv_w[(layer * 4 + k) * 256 + ch]; w1[k] = p.conv_w[(layer * 4 + k) * 256 + ch + 1]; }
        const float cb0 = p.conv_b[layer * 256 + ch], cb1 = p.conv_b[layer * 256 + ch + 1];
        float xa[11], xb[11];
#pragma unroll
        for (int i = 0; i < 11; ++i) {
            const int t = t0 + tq * 8 - 3 + i;
            unsigned w = 0u;
            if (t >= 0) w = *(const unsigned*)(XLRU + ((size_t)b * SEQ + t) * 256 + ch);
            xa[i] = bflo(w); xb[i] = bfhi(w);
        }
#pragma unroll
        for (int i = 0; i < 8; ++i) {
            const float y0 = cb0 + w0[0] * xa[i] + w0[1] * xa[i + 1] + w0[2] * xa[i + 2] + w0[3] * xa[i + 3];
            const float y1 = cb1 + w1[0] * xb[i] + w1[1] * xb[i + 1] + w1[2] * xb[i + 2] + w1[3] * xb[i + 3];
            *(unsigned*)(xcb + (tq * 8 + i) * 264 + ch) = pk2(y0, y1);
        }
    }
    __syncthreads();
    {
        const int g = wave >> 1, jh = wave & 1, l31 = lane & 31, hi = lane >> 5;
        const int j = jh * 32 + l31, ch = g * 64 + j;
        f32x16 accR = {}, accI = {};
#pragma unroll
        for (int kb = 0; kb < 4; ++kb) {
            const bf16x8 af = *(const bf16x8*)(xcb + l31 * 264 + g * 64 + kb * 16 + hi * 8);
            const bf16x8 br = *(const bf16x8*)(WAT + ((size_t)((layer * 2 + 0) * 4 + g) * 64 + j) * 64 + kb * 16 + hi * 8);
            const bf16x8 bi = *(const bf16x8*)(WAT + ((size_t)((layer * 2 + 1) * 4 + g) * 64 + j) * 64 + kb * 16 + hi * 8);
            accR = __builtin_amdgcn_mfma_f32_32x32x16_bf16(af, br, accR, 0, 0, 0);
            accI = __builtin_amdgcn_mfma_f32_32x32x16_bf16(af, bi, accI, 0, 0, 0);
        }
        const float ba = p.lru_ba[layer * 256 + ch], bx = p.lru_bx[layer * 256 + ch], lam = p.lru_lambda[layer * 256 + ch];
        const float sp = fmaxf(-lam, 0.f) + log1pf(__expf(-fabsf(lam)));
#pragma unroll
        for (int r = 0; r < 16; ++r) {
            const int t = crow(r, hi);
            const float rg = sigmoid_f(accR[r] + ba), ig = sigmoid_f(accI[r] + bx);
            const float log_a = -8.0f * rg * sp;
            const float a = __expf(log_a);
            const float xc = bf2f(xcb[t * 264 + ch]);
            const float bt = sqrtf(fmaxf(-expm1f(2.0f * log_a), 0.f)) * (ig * xc);
            aL[t * 256 + ch] = a; bL[t * 256 + ch] = bt;
            if ((r & 3) == 3) asm volatile("" ::: "memory");
        }
    }
    __syncthreads();
    {
        const int ch = tid & 255, half = tid >> 8;
        float hl[16], ca[16]; float hloc = 0.f, cum = 1.f;
#pragma unroll
        for (int i = 0; i < 16; ++i) { const int t = half * 16 + i; const float a = aL[t * 256 + ch], bt = bL[t * 256 + ch]; hloc = a * hloc + bt; cum *= a; hl[i] = hloc; ca[i] = cum; }
        ex[(half * 2 + 0) * 256 + ch] = cum; ex[(half * 2 + 1) * 256 + ch] = hloc;
        __syncthreads();
        if (MODE == 0) {
            if (half == 0) {
                const float A1 = ex[(2 + 0) * 256 + ch], H1 = ex[(2 + 1) * 256 + ch];
                AGG[((size_t)(b * 128 + c) * 2 + 0) * 256 + ch] = cum * A1;
                AGG[((size_t)(b * 128 + c) * 2 + 1) * 256 + ch] = A1 * hloc + H1;
            }
        } else {
            float carry = 0.f;
            for (int cc = 0; cc < c; ++cc) {
                const float Ac = AGG[((size_t)(b * 128 + cc) * 2 + 0) * 256 + ch], Hc = AGG[((size_t)(b * 128 + cc) * 2 + 1) * 256 + ch];
                carry = Ac * carry + Hc;
            }
            if (half == 1) carry = ex[0 * 256 + ch] * carry + ex[1 * 256 + ch];
#pragma unroll
            for (int i = 0; i < 16; ++i) {
                const int t = half * 16 + i; const size_t row = r0 + t;
                const float hv = hl[i] + ca[i] * carry;
                const float gs = bf2f(GLRU[row * 256 + ch]);
                Y[row * 1024 + 512 + ch] = (bf16_t)f2bf(hv * gs);
                if ((i & 3) == 3) asm volatile("" ::: "memory");
            }
        }
    }
    __syncthreads();
}

__device__ __forceinline__ void sg_item(int item, int layer, const Params& p, unsigned char* ldsb) {
    unsigned char* ws = p.ws;
    int tid = threadIdx.x; asm volatile("" : "+v"(tid)); const int lane = tid & 63, wave = tid >> 6;
    const size_t r0 = (size_t)item * 128;
    const bf16_t* SGU = (const bf16_t*)(ws + WS_SGU);
    const bf16_t* SGV = (const bf16_t*)(ws + WS_SGV);
    const bf16_t* GSG = (const bf16_t*)(ws + WS_GSG);
    const bf16_t* SGW = (const bf16_t*)(ws + WS_SGW);
    bf16_t* Y = (bf16_t*)(ws + WS_Y);
    bf16_t* vn = (bf16_t*)ldsb;
    {
        const f32x4 lg = *(const f32x4*)(p.sg_ln_g + layer * 256 + lane * 4), lb = *(const f32x4*)(p.sg_ln_b + layer * 256 + lane * 4);
        for (int i = 0; i < 16; ++i) {
            const int t = wave * 16 + i;
            const uint2 w = *(const uint2*)(SGV + (r0 + t) * 256 + lane * 4);
            f32x4 v = (f32x4){bflo(w.x), bfhi(w.x), bflo(w.y), bfhi(w.y)};
            const float mu = wave_sum((v.x + v.y) + (v.z + v.w)) * (1.f / 256.f);
            v = v - mu;
            const float var = wave_sum((v.x * v.x + v.y * v.y) + (v.z * v.z + v.w * v.w)) * (1.f / 256.f);
            const float rs = rsqrtf(var + EPS);
            v = (v * rs) * lg + lb;
            uint2 o; o.x = pk2(v.x, v.y); o.y = pk2(v.z, v.w);
            *(uint2*)(vn + t * 260 + lane * 4) = o;
        }
    }
    __syncthreads();
    {
        const int g = wave >> 1, dh = wave & 1, l31 = lane & 31, hi = lane >> 5;
        const int ch = g * 64 + dh * 32 + l31;
        f32x16 acc[4];
#pragma unroll
        for (int tt = 0; tt < 4; ++tt) acc[tt] = (f32x16){};
        const bf16_t* Wg = SGW + (size_t)(layer * 4 + g) * 128 * 128;
#pragma unroll
        for (int kb = 0; kb < 8; ++kb) {
            bf16x8 bfr;
#pragma unroll
            for (int i = 0; i < 8; ++i) bfr[i] = (short)vn[(kb * 16 + hi * 8 + i) * 260 + ch];
#pragma unroll
            for (int tt = 0; tt < 4; ++tt) {
                if (tt >= (kb >> 1)) {
                    const bf16x8 af = *(const bf16x8*)(Wg + (size_t)(tt * 32 + l31) * 128 + kb * 16 + hi * 8);
                    acc[tt] = __builtin_amdgcn_mfma_f32_32x32x16_bf16(af, bfr, acc[tt], 0, 0, 0);
                }
            }
            asm volatile("" ::: "memory");
        }
#pragma unroll
        for (int tt = 0; tt < 4; ++tt)
#pragma unroll
            for (int r = 0; r < 16; ++r) {
                const int t = tt * 32 + crow(r, hi); const size_t row = r0 + t;
                const float z = acc[tt][r] + p.sg_b[(layer * 4 + g) * 128 + t];
                const float u = bf2f(SGU[row * 256 + ch]), gs = bf2f(GSG[row * 256 + ch]);
                Y[row * 1024 + 768 + ch] = (bf16_t)f2bf(u * z * gs);
                if ((r & 3) == 3) asm volatile("" ::: "memory");
            }
    }
    __syncthreads();
}

__device__ __forceinline__ void attn_naive(const Params& p) {
    unsigned char* ws = p.ws;
    int tid = threadIdx.x; asm volatile("" : "+v"(tid)); const int lane = tid & 63, wave = tid >> 6;
    const bf16_t* Q = (const bf16_t*)(ws + WS_Q); const bf16_t* K = (const bf16_t*)(ws + WS_K); const bf16_t* V = (const bf16_t*)(ws + WS_V);
    const bf16_t* GATT = (const bf16_t*)(ws + WS_GATT);
    const float* FC = (const float*)(ws + WS_FC);
    bf16_t* Y = (bf16_t*)(ws + WS_Y);
    for (int bi = blockIdx.x; bi < 512; bi += gridDim.x) {
        const int bh = bi >> 4, j = bi & 15, b = bh >> 3, h = bh & 7;
        const int tb = wave * 16 + ((wave & 1) ? 15 - j : j);
        const int t = tb * 32 + (lane >> 1), dh = (lane & 1) * 32;
        const size_t row = (size_t)b * SEQ + t;
        float q[32], o[32];
#pragma unroll
        for (int i = 0; i < 4; ++i) {
            const uint4 w = *(const uint4*)(Q + row * 512 + h * 64 + dh + i * 8);
            q[i * 8 + 0] = bflo(w.x); q[i * 8 + 1] = bfhi(w.x); q[i * 8 + 2] = bflo(w.y); q[i * 8 + 3] = bfhi(w.y);
            q[i * 8 + 4] = bflo(w.z); q[i * 8 + 5] = bfhi(w.z); q[i * 8 + 6] = bflo(w.w); q[i * 8 + 7] = bfhi(w.w);
        }
#pragma unroll
        for (int d = 0; d < 32; ++d) o[d] = 0.f;
        const float* Fc = FC + (size_t)bh * SEQ;
        const float Fq = Fc[t];
        float m = -INFINITY, l = 0.f;
        const int tmax = tb * 32 + 31;
        for (int s = 0; s <= tmax; ++s) {
            const uint4* kp = (const uint4*)(K + ((size_t)b * SEQ + s) * 512 + h * 64 + dh);
            float dot = 0.f;
#pragma unroll
            for (int i = 0; i < 4; ++i) {
                const uint4 w = kp[i];
                dot += q[i * 8 + 0] * bflo(w.x) + q[i * 8 + 1] * bfhi(w.x) + q[i * 8 + 2] * bflo(w.y) + q[i * 8 + 3] * bfhi(w.y)
                     + q[i * 8 + 4] * bflo(w.z) + q[i * 8 + 5] * bfhi(w.z) + q[i * 8 + 6] * bflo(w.w) + q[i * 8 + 7] * bfhi(w.w);
            }
            dot += __shfl_xor(dot, 1);
            float logit = dot + (Fq - Fc[s]);
            if (s > t) logit = -INFINITY;
            const float mn = fmaxf(m, logit);
            const float alpha = exp2f(m - mn), pr = exp2f(logit - mn);
            l = l * alpha + pr; m = mn;
            const uint4* vp = (const uint4*)(V + ((size_t)b * SEQ + s) * 512 + h * 64 + dh);
#pragma unroll
            for (int i = 0; i < 4; ++i) {
                const uint4 w = vp[i];
                o[i * 8 + 0] = o[i * 8 + 0] * alpha + pr * bflo(w.x); o[i * 8 + 1] = o[i * 8 + 1] * alpha + pr * bfhi(w.x);
                o[i * 8 + 2] = o[i * 8 + 2] * alpha + pr * bflo(w.y); o[i * 8 + 3] = o[i * 8 + 3] * alpha + pr * bfhi(w.y);
                o[i * 8 + 4] = o[i * 8 + 4] * alpha + pr * bflo(w.z); o[i * 8 + 5] = o[i * 8 + 5] * alpha + pr * bfhi(w.z);
                o[i * 8 + 6] = o[i * 8 + 6] * alpha + pr * bflo(w.w); o[i * 8 + 7] = o[i * 8 + 7] * alpha + pr * bfhi(w.w);
            }
        }
        const float rl = 1.f / l;
#pragma unroll
        for (int i = 0; i < 4; ++i) {
            const uint4 gw = *(const uint4*)(GATT + row * 512 + h * 64 + dh + i * 8);
            uint4 ov;
            ov.x = pk2(o[i * 8 + 0] * rl * bflo(gw.x), o[i * 8 + 1] * rl * bfhi(gw.x));
            ov.y = pk2(o[i * 8 + 2] * rl * bflo(gw.y), o[i * 8 + 3] * rl * bfhi(gw.y));
            ov.z = pk2(o[i * 8 + 4] * rl * bflo(gw.z), o[i * 8 + 5] * rl * bfhi(gw.z));
            ov.w = pk2(o[i * 8 + 6] * rl * bflo(gw.w), o[i * 8 + 7] * rl * bfhi(gw.w));
            *(uint4*)(Y + row * 1024 + h * 64 + dh + i * 8) = ov;
        }
    }
}

__global__ void __launch_bounds__(NTHREADS) fwd_megakernel(Params p) {
    extern __shared__ __attribute__((aligned(16))) unsigned char lds[];
    cg::grid_group grid = cg::this_grid();
    unsigned char* ws = p.ws;
    const int G = gridDim.x, blk = blockIdx.x;
    ProjOut PO{(bf16_t*)(ws + WS_Q), (bf16_t*)(ws + WS_K), (bf16_t*)(ws + WS_V), (bf16_t*)(ws + WS_GATT), (bf16_t*)(ws + WS_XLRU), (bf16_t*)(ws + WS_GLRU),
               (bf16_t*)(ws + WS_SGU), (bf16_t*)(ws + WS_SGV), (bf16_t*)(ws + WS_GSG)};

    p0_prologue(p, (float*)lds);
    grid.sync();
    row_pass<true, true>(p, 0, 0, p.x, nullptr, (float*)lds);
    grid.sync();
    for (int layer = 0; layer < NLAYER; ++layer) {
        { StoreProj st{PO}; gemm_naive((const bf16_t*)(ws + WS_H), (const bf16_t*)(ws + WS_WINT + layer * WS_WINT_STRIDE), NPROJ, (float*)lds, st); }
        grid.sync();
        for (int it = blk; it < 32 + 512 + 128; it += G) {
            if (it < 32) fcum_item(it, (const float*)(ws + WS_LS), (float*)(ws + WS_FC), (float*)lds);
            else if (it < 32 + 512) lru_item<0>(it - 32, layer, p, lds);
            else sg_item(it - 32 - 512, layer, p, lds);
        }
        grid.sync();
        attn_naive(p);
        for (int it = blk; it < 512; it += G) lru_item<1>(it, layer, p, lds);
        grid.sync();
        { StoreBf16 st{(bf16_t*)(ws + WS_YOUT), 1024}; gemm_naive((const bf16_t*)(ws + WS_Y), (const bf16_t*)(ws + WS_WOUTT + (size_t)layer * 2 * MiB), 1024, (float*)lds, st); }
        grid.sync();
        if (layer == 0) { row_pass<false, true>(p, 0, 1, p.x, p.out, (float*)lds); grid.sync(); }
        else row_pass<false, false>(p, 1, 1, p.out, p.out, (float*)lds);
    }
}

extern "C" void kernel_launch(void* const* d_in, const int* in_sizes, int n_in, void* d_out, int out_size, void* d_ws, size_t ws_size, hipStream_t stream) {
    static int grid = 0;
    if (grid == 0) {
        if (n_in != 20 || out_size != MROWS * DM || ws_size < WS_END) { fprintf(stderr, "kernel_launch: unexpected shapes (n_in %d out %d ws %zu)\n", n_in, out_size, ws_size); grid = -1; return; }
        int dev = 0, cus = 0, per_cu = 0;
        if (hipGetDevice(&dev) != hipSuccess || hipDeviceGetAttribute(&cus, hipDeviceAttributeMultiprocessorCount, dev) != hipSuccess) { grid = -1; return; }
        if (hipFuncSetAttribute((const void*)fwd_megakernel, hipFuncAttributeMaxDynamicSharedMemorySize, LDS_BYTES) != hipSuccess) { fprintf(stderr, "kernel_launch: hipFuncSetAttribute failed\n"); grid = -1; return; }
        if (hipOccupancyMaxActiveBlocksPerMultiprocessor(&per_cu, (const void*)fwd_megakernel, NTHREADS, LDS_BYTES) != hipSuccess || per_cu < 1) { fprintf(stderr, "kernel_launch: occupancy query says %d\n", per_cu); per_cu = 1; }
        (void)hipGetLastError();
        grid = cus;
    }
    if (grid < 0) return;
    Params p{};
    p.x = (const float*)d_in[0]; p.c = (const float*)d_in[1]; p.ada_w = (const float*)d_in[2]; p.ada_b = (const float*)d_in[3]; p.pre_g = (const float*)d_in[4];
    p.post_g = (const float*)d_in[5]; p.w_in = (const float*)d_in[6]; p.b_f = (const float*)d_in[7]; p.conv_w = (const float*)d_in[8]; p.conv_b = (const float*)d_in[9];
    p.lru_wa = (const float*)d_in[10]; p.lru_ba = (const float*)d_in[11]; p.lru_wx = (const float*)d_in[12]; p.lru_bx = (const float*)d_in[13]; p.lru_lambda = (const float*)d_in[14];
    p.sg_ln_g = (const float*)d_in[15]; p.sg_ln_b = (const float*)d_in[16]; p.sg_w = (const float*)d_in[17]; p.sg_b = (const float*)d_in[18]; p.w_out = (const float*)d_in[19];
    p.out = (float*)d_out; p.ws = (unsigned char*)d_ws;
    void* args[] = {&p};
    hipError_t e = hipLaunchCooperativeKernel((const void*)fwd_megakernel, dim3(grid), dim3(NTHREADS), args, LDS_BYTES, stream);
    if (e != hipSuccess) fprintf(stderr, "kernel_launch: cooperative launch failed: %s (grid %d)\n", hipGetErrorString(e), grid);
}
```

```cpp
#include <hip/hip_runtime.h>
#include <hip/hip_cooperative_groups.h>
#include <cstdio>
#include <cstdint>
namespace cg = cooperative_groups;

typedef unsigned short bf16_t;
typedef short bf16x8 __attribute__((ext_vector_type(8)));
typedef float f32x16 __attribute__((ext_vector_type(16)));
typedef float f32x4 __attribute__((ext_vector_type(4)));

constexpr int NB = 4, SEQ = 4096, DM = 1024, MROWS = NB * SEQ, NLAYER = 2;
constexpr int DIN = 3336, NPROJ = 3328;
constexpr int FCOL = 1536;
constexpr int NTHREADS = 512;
constexpr float EPS = 1e-6f;
constexpr float LOG2E = 1.4426950408889634f;
constexpr float QSCALE = 0.125f * LOG2E;

constexpr size_t MiB = 1u << 20;
constexpr size_t WS_WINT = 2 * MiB;
constexpr size_t WS_WINT_STRIDE = 7 * MiB;
constexpr size_t WS_WOUTT = 16 * MiB;
constexpr size_t WS_MOD = 20 * MiB;
constexpr size_t WS_SGW = 21 * MiB;
constexpr size_t WS_WAT = 22 * MiB;
constexpr size_t WS_LS = 23 * MiB;
constexpr size_t WS_FC = 24 * MiB;
constexpr size_t WS_AGG = 25 * MiB;
constexpr size_t WS_H = 32 * MiB;
constexpr size_t WS_Q = 64 * MiB, WS_K = 80 * MiB, WS_V = 96 * MiB, WS_GATT = 112 * MiB;
constexpr size_t WS_XLRU = 128 * MiB, WS_GLRU = 136 * MiB, WS_SGU = 144 * MiB, WS_SGV = 152 * MiB, WS_GSG = 160 * MiB;
constexpr size_t WS_Y = 168 * MiB;
constexpr size_t WS_YOUT = 64 * MiB;
constexpr size_t WS_END = 200 * MiB;

constexpr int LDS_BYTES = 147456;

struct Params {
    const float *x, *c, *ada_w, *ada_b, *pre_g, *post_g, *w_in, *b_f, *conv_w, *conv_b, *lru_wa, *lru_ba, *lru_wx, *lru_bx, *lru_lambda,
        *sg_ln_g, *sg_ln_b, *sg_w, *sg_b, *w_out;
    float* out; unsigned char* ws;
};

__device__ __forceinline__ unsigned f2bf(float f) { unsigned u = __float_as_uint(f); return (u + 0x7fffu + ((u >> 16) & 1u)) >> 16; }
__device__ __forceinline__ unsigned pk2(float lo, float hi) { return f2bf(lo) | (f2bf(hi) << 16); }
__device__ __forceinline__ float bf2f(unsigned h) { return __uint_as_float(h << 16); }
__device__ __forceinline__ float bflo(unsigned w) { return __uint_as_float(w << 16); }
__device__ __forceinline__ float bfhi(unsigned w) { return __uint_as_float(w & 0xffff0000u); }
__device__ __forceinline__ float wave_sum(float v) {
#pragma unroll
    for (int o = 1; o < 64; o <<= 1) v += __shfl_xor(v, o);
    return v;
}
__device__ __forceinline__ float sigmoid_f(float v) { return 1.f / (1.f + __expf(-v)); }
__device__ __forceinline__ float silu_f(float v) { return v / (1.f + __expf(-v)); }
__device__ __forceinline__ float gelu_f(float v) { const float u = 1.5957691216057308f * (v + 0.044715f * v * v * v); return v / (1.f + __expf(-u)); }
__device__ __forceinline__ int crow(int r, int hi) { return (r & 3) + 8 * (r >> 2) + 4 * hi; }

struct ProjOut { bf16_t *Q, *K, *V, *GATT, *XLRU, *GLRU, *SGU, *SGV, *GSG; };
__device__ __forceinline__ void proj_store(const ProjOut& P, int row, int n, float v) {
    if (n < 512) P.Q[(size_t)row * 512 + n] = (bf16_t)f2bf(v * QSCALE);
    else if (n < 1024) P.K[(size_t)row * 512 + n - 512] = (bf16_t)f2bf(v);
    else if (n < 1536) P.V[(size_t)row * 512 + n - 1024] = (bf16_t)f2bf(v);
    else if (n < 2048) P.GATT[(size_t)row * 512 + n - 1536] = (bf16_t)f2bf(silu_f(v));
    else if (n < 2304) P.XLRU[(size_t)row * 256 + n - 2048] = (bf16_t)f2bf(v);
    else if (n < 2560) P.GLRU[(size_t)row * 256 + n - 2304] = (bf16_t)f2bf(silu_f(v));
    else if (n < 2816) P.SGU[(size_t)row * 256 + n - 2560] = (bf16_t)f2bf(gelu_f(v));
    else if (n < 3072) P.SGV[(size_t)row * 256 + n - 2816] = (bf16_t)f2bf(gelu_f(v));
    else P.GSG[(size_t)row * 256 + n - 3072] = (bf16_t)f2bf(silu_f(v));
}

namespace pg8 {
#define PG8_LAS __attribute__((address_space(3)))
typedef unsigned short bf16_t;
typedef short bf16x8 __attribute__((ext_vector_type(8)));
typedef float f32x4 __attribute__((ext_vector_type(4)));
typedef unsigned u32x4 __attribute__((ext_vector_type(4)));
constexpr int BM = 256, BK = 64, HALF = 128, HTB = HALF * BK * 2  , STAGE_BYTES = 8 * HTB, NXCD = 8, WGM = 8;

__host__ __device__ __forceinline__ int lds_byte(int r, int c) { const int st = (r >> 4) * 2 + (c >> 5), rr = r & 15, cc = c & 31, ob = rr * 64 + cc * 2; return st * 1024 + (ob ^ (((ob >> 9) & 1) << 5)); }
__host__ __device__ __forceinline__ void stage_rc(int b, int& R, int& C) { const int st = b / 1024, sb = b % 1024, swz = sb ^ (((sb >> 9) & 1) << 5); R = (st >> 1) * 16 + swz / 64; C = (st & 1) * 32 + (swz % 64) / 2; }
__host__ __device__ __forceinline__ int perm32(int rho) { const int n = rho >> 4, i = rho & 15; return 8 * (i >> 2) + 4 * n + (i & 3); }

struct Unit { int pm, pn; };
struct Gemm { const bf16_t* A; const bf16_t* Bt; int M, N, K; };

struct StaticOrder {
    int nM, nN, nwg, G, c;
    __host__ __device__ void init(int M, int N, int G_, int c_) { nM = M / BM; nN = N / BM; nwg = nM * nN; G = G_; c = c_; }
    __host__ __device__ bool next(int i, Unit& u) const {
        const long L = (long)i * G + c; if (L >= nwg) return false;
        int wgid = (int)L; { const int q = nwg / NXCD, r = nwg % NXCD, xcd = wgid % NXCD, off = wgid / NXCD; wgid = (xcd < r ? xcd * (q + 1) : r * (q + 1) + (xcd - r) * q) + off; }
        const int nig = WGM * nN, gid = wgid / nig, fm = gid * WGM, gsz = (nM - fm) < WGM ? (nM - fm) : WGM;
        u.pm = fm + ((wgid % nig) % gsz); u.pn = (wgid % nig) / gsz; return true;
    }
    __device__ __forceinline__ void a_ready(const Unit&) const {}
    __device__ __forceinline__ void done(const Unit&) const {}
};

__device__ __forceinline__ unsigned cvt_pk_bf16(float lo, float hi) { unsigned r; asm volatile("v_cvt_pk_bf16_f32 %0, %1, %2" : "=v"(r) : "v"(lo), "v"(hi)); return r; }
typedef float f32x2 __attribute__((ext_vector_type(2)));
__device__ __forceinline__ f32x2 gelu_pk(f32x2 v) {
    const f32x2 av = __builtin_elementwise_abs(v), d = av * 0.2316418882f + 1.0f;
    f32x2 t; t.x = __builtin_amdgcn_rcpf(d.x); t.y = __builtin_amdgcn_rcpf(d.y);
    f32x2 q = t * 0.5307027145f + (-0.7265760135f); q = q * t + 0.7107068705f; q = q * t + (-0.142248368f); q = q * t + 0.127414796f; q = q * t;
    const f32x2 s = (v * v) * (-0.72134752044f);
    f32x2 e; e.x = __builtin_amdgcn_exp2f(s.x); e.y = __builtin_amdgcn_exp2f(s.y);
    const f32x2 m = v * (q * e), r = v - m;
    f32x2 o; o.x = v.x < 0.f ? m.x : r.x; o.y = v.y < 0.f ? m.y : r.y; return o;
}

template <int ACT  > struct EpiBf16 {
    static constexpr bool PERM = true, AFTER_DRAIN = false; static_assert(ACT == 0 || ACT == 1, "EpiBf16: ACT is 0 (none) or 1 (gelu_pk)");
    bf16_t* O; int ldc; const float* bias; int split_cols; size_t split_stride; float scale0;
    __device__ __forceinline__ void operator()(const f32x4 (&acc)[2][2][4][2], const Unit& u, int wr, int wc, int fr, int fq) const {
        const int row0 = u.pm * BM + wr * 64 + fr; int colt = u.pn * BM; bf16_t* base = O;
        float sc = 1.f; if (split_cols) { const int t = colt / split_cols; base += (size_t)t * split_stride; colt -= t * split_cols; if (t == 0) sc = scale0; }
        const int col0 = colt + wc * 32 + 8 * fq, bcol0 = u.pn * BM + wc * 32 + 8 * fq;
        f32x4 bv[2][2];
#pragma unroll
        for (int bj = 0; bj < 2; ++bj)
#pragma unroll
            for (int n = 0; n < 2; ++n) bv[bj][n] = bias ? *(const f32x4*)(bias + bcol0 + bj * HALF + 4 * n) : (f32x4){0.f, 0.f, 0.f, 0.f};
#pragma unroll
        for (int ai = 0; ai < 2; ++ai)
#pragma unroll
            for (int m = 0; m < 4; ++m) { bf16_t* rowp = base + (size_t)(row0 + ai * HALF + m * 16) * ldc + col0;
#pragma unroll
                for (int bj = 0; bj < 2; ++bj) { f32x4 v0 = acc[ai][bj][m][0] + bv[bj][0], v1 = acc[ai][bj][m][1] + bv[bj][1];
                    if (ACT == 1) { f32x2 a = gelu_pk((f32x2){v0[0], v0[1]}), b = gelu_pk((f32x2){v0[2], v0[3]}), c = gelu_pk((f32x2){v1[0], v1[1]}), d = gelu_pk((f32x2){v1[2], v1[3]});
                        v0 = (f32x4){a.x, a.y, b.x, b.y}; v1 = (f32x4){c.x, c.y, d.x, d.y}; }
                    v0 = v0 * sc; v1 = v1 * sc; u32x4 w; w.x = cvt_pk_bf16(v0[0], v0[1]); w.y = cvt_pk_bf16(v0[2], v0[3]); w.z = cvt_pk_bf16(v1[0], v1[1]); w.w = cvt_pk_bf16(v1[2], v1[3]);
                    *(u32x4*)(rowp + bj * HALF) = w; } }
    }
};

struct EpiProj {
    static constexpr bool PERM = true, AFTER_DRAIN = false;
    ::ProjOut P;
    __device__ __forceinline__ void operator()(const f32x4 (&acc)[2][2][4][2], const Unit& u, int wr, int wc, int fr, int fq) const {
        const int pn = u.pn;
        bf16_t* base; int ldc = 512, colt = 0, act = 0; float sc = 1.f;
        if (pn < 2) { base = P.Q; colt = pn * 256; sc = ::QSCALE; }
        else if (pn < 4) { base = P.K; colt = (pn - 2) * 256; }
        else if (pn < 6) { base = P.V; colt = (pn - 4) * 256; }
        else if (pn < 8) { base = P.GATT; colt = (pn - 6) * 256; act = 1; }
        else { ldc = 256; base = (pn == 8) ? P.XLRU : (pn == 9) ? P.GLRU : (pn == 10) ? P.SGU : (pn == 11) ? P.SGV : P.GSG; act = (pn == 8) ? 0 : ((pn == 10 || pn == 11) ? 2 : 1); }
        const int row0 = u.pm * BM + wr * 64 + fr, col0 = colt + wc * 32 + 8 * fq;
#pragma unroll
        for (int ai = 0; ai < 2; ++ai)
#pragma unroll
            for (int m = 0; m < 4; ++m) { bf16_t* rowp = base + (size_t)(row0 + ai * HALF + m * 16) * ldc + col0;
#pragma unroll
                for (int bj = 0; bj < 2; ++bj) { f32x4 v0 = acc[ai][bj][m][0], v1 = acc[ai][bj][m][1];
                    if (act == 1) {
#pragma unroll
                        for (int e = 0; e < 4; ++e) { v0[e] = ::silu_f(v0[e]); v1[e] = ::silu_f(v1[e]); }
                    } else if (act == 2) {
#pragma unroll
                        for (int e = 0; e < 4; ++e) { v0[e] = ::gelu_f(v0[e]); v1[e] = ::gelu_f(v1[e]); }
                    }
                    v0 = v0 * sc; v1 = v1 * sc; u32x4 w; w.x = cvt_pk_bf16(v0[0], v0[1]); w.y = cvt_pk_bf16(v0[2], v0[3]); w.z = cvt_pk_bf16(v1[0], v1[1]); w.w = cvt_pk_bf16(v1[2], v1[3]);
                    *(u32x4*)(rowp + bj * HALF) = w; } }
    }
};

template <class Epi, class Sched, bool ALIGN_EPI = false, bool SP2 = false>
__device__ __forceinline__ void gemm_phase(PG8_LAS unsigned char* lds, const Gemm g, const Sched& S, const Epi& E) {
    int tid = threadIdx.x; asm volatile("" : "+v"(tid)); const int wid = __builtin_amdgcn_readfirstlane(tid >> 6), lane = tid & 63, wr = wid >> 2, wc = wid & 3, fr = lane & 15, fq = lane >> 4;
    const int K = g.K, nt = K / BK;
    unsigned voffA[2], voffB[2];
#pragma unroll
    for (int i = 0; i < 2; ++i) { int R, C; stage_rc(tid * 16 + i * 8192, R, C); const int Rb = Epi::PERM ? ((R & ~31) + perm32(R & 31)) : R;
        voffA[i] = (unsigned)(R * K + C) * 2u; voffB[i] = (unsigned)(Rb * K + C) * 2u; }
    const size_t kstep = (size_t)(BK * 2);
    const size_t hstep = (size_t)HALF * K * 2;
    const size_t tstep = 2 * hstep;
    const unsigned ldsw = (unsigned)wid * 1024u;
    const int aoff = lds_byte(wr * 64 + fr, fq * 8), boff = lds_byte(wc * 32 + fr, fq * 8);
#define PG8_SA(b, h) (((b) * 2 + (h)) * HTB)
#define PG8_SB(b, h) ((4 + (b) * 2 + (h)) * HTB)
#define PG8_STAGE(bufoff, gbase, voff) do { _Pragma("unroll") for (int _i = 0; _i < 2; ++_i) \
        __builtin_amdgcn_global_load_lds((const unsigned*)((const char*)(gbase) + (voff)[_i]), (PG8_LAS unsigned*)(lds + (bufoff) + ldsw + _i * 8192), 16, 0, 0); } while (0)
#define PG8_LDA(dst, b, h) do { _Pragma("unroll") for (int m = 0; m < 4; ++m) _Pragma("unroll") for (int k = 0; k < 2; ++k) dst[m][k] = *(const PG8_LAS bf16x8*)(lds + PG8_SA(b, h) + aoff + m * 2048 + k * 1024); } while (0)
#define PG8_LDB(dst, b, h) do { _Pragma("unroll") for (int n = 0; n < 2; ++n) _Pragma("unroll") for (int k = 0; k < 2; ++k) dst[n][k] = *(const PG8_LAS bf16x8*)(lds + PG8_SB(b, h) + boff + n * 2048 + k * 1024); } while (0)
#define PG8_MMA(ai, bj, At, Bt) do { __builtin_amdgcn_s_setprio(1); _Pragma("unroll") for (int m = 0; m < 4; ++m) _Pragma("unroll") for (int n = 0; n < 2; ++n) _Pragma("unroll") for (int k = 0; k < 2; ++k) \
        acc[ai][bj][m][n] = __builtin_amdgcn_mfma_f32_16x16x32_bf16(Bt[n][k], At[m][k], acc[ai][bj][m][n], 0, 0, 0); __builtin_amdgcn_s_setprio(0); } while (0)
#define PG8_WAIT_V(n) asm volatile("s_waitcnt vmcnt(" #n ")" ::: "memory")
#define PG8_WAIT_L(n) asm volatile("s_waitcnt lgkmcnt(" #n ")" ::: "memory")
#define PG8_BAR __builtin_amdgcn_s_barrier()
#define PG8_SCHED __builtin_amdgcn_sched_barrier(0)
    Unit cur, nxt; int ui = 0;
    if (!S.next(0, cur)) return;
    f32x4 acc[2][2][4][2];
#pragma unroll
    for (int a = 0; a < 2; ++a)
#pragma unroll
        for (int b = 0; b < 2; ++b)
#pragma unroll
            for (int m = 0; m < 4; ++m)
#pragma unroll
                for (int n = 0; n < 2; ++n) acc[a][b][m][n] = (f32x4){0.f, 0.f, 0.f, 0.f};
    bf16x8 At[4][2], B0[2][2], B1[2][2];
    const char* cA = (const char*)g.A + (size_t)cur.pm * tstep; const char* cB = (const char*)g.Bt + (size_t)cur.pn * tstep;
    S.a_ready(cur);
    if constexpr (SP2) {
        PG8_STAGE(PG8_SB(0, 0), cB, voffB); PG8_STAGE(PG8_SB(0, 1), cB + hstep, voffB); PG8_STAGE(PG8_SA(0, 0), cA, voffA); PG8_STAGE(PG8_SA(0, 1), cA + hstep, voffA);
        if (wr == 1) PG8_BAR;
        PG8_WAIT_V(2); PG8_BAR;
        PG8_STAGE(PG8_SB(1, 0), cB + kstep, voffB); PG8_STAGE(PG8_SA(1, 0), cA + kstep, voffA); PG8_STAGE(PG8_SB(1, 1), cB + hstep + kstep, voffB);
        PG8_WAIT_V(6); PG8_BAR;
    } else {
        PG8_STAGE(PG8_SB(0, 0), cB, voffB); PG8_STAGE(PG8_SA(0, 0), cA, voffA); PG8_STAGE(PG8_SB(0, 1), cB + hstep, voffB); PG8_STAGE(PG8_SA(0, 1), cA + hstep, voffA);
        if (wr == 1) PG8_BAR;
        PG8_WAIT_V(4); PG8_BAR;
        PG8_STAGE(PG8_SB(1, 0), cB + kstep, voffB); PG8_STAGE(PG8_SA(1, 0), cA + kstep, voffA); PG8_STAGE(PG8_SB(1, 1), cB + hstep + kstep, voffB);
        PG8_WAIT_V(6); PG8_BAR;
    }
    for (;;) {
        const bool has_next = S.next(ui + 1, nxt);
        const char* nA = has_next ? (const char*)g.A + (size_t)nxt.pm * tstep : cA; const char* nB = has_next ? (const char*)g.Bt + (size_t)nxt.pn * tstep : cB;
        for (int t = 0; t < nt; t += 2) {
            const bool last = (t == nt - 2);
            const char* a1 = cA + (size_t)(t + 1) * kstep;
            const char* a2 = last ? nA : cA + (size_t)(t + 2) * kstep; const char* b2 = last ? nB : cB + (size_t)(t + 2) * kstep;
            const char* a3 = a2 + kstep; const char* b3 = b2 + kstep;
            if (last && has_next) S.a_ready(nxt);
            if constexpr (SP2) {
            PG8_LDB(B0, 0, 0); PG8_LDB(B1, 0, 1); PG8_SCHED; PG8_LDA(At, 0, 0); PG8_STAGE(PG8_SA(1, 1), a1 + hstep, voffA);
            PG8_WAIT_V(8); PG8_WAIT_L(0); PG8_BAR; PG8_MMA(0, 0, At, B0); PG8_MMA(0, 1, At, B1); PG8_BAR; PG8_SCHED;
            PG8_LDA(At, 0, 1); PG8_STAGE(PG8_SB(0, 0), b2, voffB); PG8_STAGE(PG8_SB(0, 1), b2 + hstep, voffB); PG8_STAGE(PG8_SA(0, 0), a2, voffA);
            PG8_WAIT_V(8); PG8_WAIT_L(0); PG8_BAR; PG8_MMA(1, 0, At, B0); PG8_MMA(1, 1, At, B1); PG8_BAR; PG8_SCHED;
            PG8_LDB(B0, 1, 0); PG8_LDB(B1, 1, 1); PG8_SCHED; PG8_LDA(At, 1, 0); PG8_STAGE(PG8_SA(0, 1), a2 + hstep, voffA);
            PG8_WAIT_V(8); PG8_WAIT_L(0); PG8_BAR; PG8_MMA(0, 0, At, B0); PG8_MMA(0, 1, At, B1); PG8_BAR; PG8_SCHED;
            PG8_LDA(At, 1, 1); PG8_STAGE(PG8_SB(1, 0), b3, voffB); PG8_STAGE(PG8_SB(1, 1), b3 + hstep, voffB); PG8_STAGE(PG8_SA(1, 0), a3, voffA);
            PG8_WAIT_V(8); PG8_WAIT_L(0); PG8_BAR; PG8_MMA(1, 0, At, B0); PG8_MMA(1, 1, At, B1); PG8_BAR; PG8_SCHED;
            } else {
            PG8_LDB(B0, 0, 0); PG8_SCHED; PG8_LDA(At, 0, 0); PG8_STAGE(PG8_SA(1, 1), a1 + hstep, voffA);
            PG8_WAIT_L(8); PG8_BAR; PG8_WAIT_L(0); PG8_MMA(0, 0, At, B0); PG8_BAR; PG8_SCHED;
            PG8_LDB(B1, 0, 1); PG8_STAGE(PG8_SB(0, 0), b2, voffB);
            PG8_BAR; PG8_WAIT_L(0); PG8_MMA(0, 1, At, B1); PG8_BAR;
            PG8_LDA(At, 0, 1); PG8_STAGE(PG8_SA(0, 0), a2, voffA);
            PG8_BAR; PG8_WAIT_L(0); PG8_MMA(1, 0, At, B0); PG8_BAR; PG8_SCHED;
            PG8_STAGE(PG8_SB(0, 1), b2 + hstep, voffB);
            PG8_WAIT_V(6); PG8_BAR; PG8_MMA(1, 1, At, B1); PG8_BAR;
            PG8_LDB(B0, 1, 0); PG8_SCHED; PG8_LDA(At, 1, 0); PG8_STAGE(PG8_SA(0, 1), a2 + hstep, voffA);
            PG8_WAIT_L(8); PG8_BAR; PG8_WAIT_L(0); PG8_MMA(0, 0, At, B0); PG8_BAR; PG8_SCHED;
            PG8_LDB(B1, 1, 1); PG8_STAGE(PG8_SB(1, 0), b3, voffB);
            PG8_BAR; PG8_WAIT_L(0); PG8_MMA(0, 1, At, B1); PG8_BAR;
            PG8_LDA(At, 1, 1); PG8_STAGE(PG8_SA(1, 0), a3, voffA);
            PG8_BAR; PG8_WAIT_L(0); PG8_MMA(1, 0, At, B0); PG8_BAR; PG8_SCHED;
            PG8_STAGE(PG8_SB(1, 1), b3 + hstep, voffB);
            PG8_WAIT_V(6); PG8_BAR; PG8_MMA(1, 1, At, B1); PG8_BAR;
            }
        }
        if constexpr (ALIGN_EPI) { if (wr == 0) PG8_BAR; }
        if constexpr (!Epi::AFTER_DRAIN) { E(acc, cur, wr, wc, fr, fq); S.done(cur); }
        if (!has_next) break;
#pragma unroll
        for (int a = 0; a < 2; ++a)
#pragma unroll
            for (int b = 0; b < 2; ++b)
#pragma unroll
                for (int m = 0; m < 4; ++m)
#pragma unroll
                    for (int n = 0; n < 2; ++n) acc[a][b][m][n] = (f32x4){0.f, 0.f, 0.f, 0.f};
        cur = nxt; cA = nA; cB = nB; ++ui;
        if constexpr (ALIGN_EPI) { if (wr == 1) PG8_BAR; }
    }
    PG8_WAIT_V(0);
    if constexpr (!ALIGN_EPI) { if (wr == 0) PG8_BAR; }
    PG8_BAR;
    if constexpr (Epi::AFTER_DRAIN) { E.fused(acc, cur, wr, wc, fr, fq, lds, wid, lane); S.done(cur); }
#undef PG8_SA
#undef PG8_SB
#undef PG8_STAGE
#undef PG8_LDA
#undef PG8_LDB
#undef PG8_MMA
#undef PG8_WAIT_V
#undef PG8_WAIT_L
#undef PG8_BAR
#undef PG8_SCHED
}
}

#include <hip/hip_bf16.h>
#include <cmath>
namespace attn_body {
using bf16=__hip_bfloat16;
using bf16x8=__attribute__((ext_vector_type(8)))short;
using s16x4=__attribute__((ext_vector_type(4)))short;
using f32x16=__attribute__((ext_vector_type(16)))float;
using u32x4=__attribute__((ext_vector_type(4)))unsigned;
using f32x4=__attribute__((ext_vector_type(4)))float;
constexpr int BATCH=4,NHEAD=8,SEQ=4096,D=64,DM=NHEAD*D,ODM=1024;
constexpr int NW=8,QBLK=32,QB=QBLK*NW,KVBLK=64,NQB=SEQ/QB;
constexpr int ATTN_PITCH=DM, ATTN_UNIT_ROWS=QB;
__device__ __forceinline__ int crow(int r,int hi){return (r&3)+8*(r>>2)+4*hi;}
#define SBAR() __builtin_amdgcn_sched_barrier(0)
__device__ __forceinline__ void cmask(f32x16&p0,f32x16&p1,int jb,int qrel,int hi){
  const float NEG=-INFINITY; int kb=64*jb+4*hi;
  #pragma unroll
  for(int r=0;r<16;++r){int kv=kb+(r&3)+8*(r>>2); if(kv>qrel)p0[r]=NEG; if(kv+32>qrel)p1[r]=NEG;}
}

constexpr int NSLOT=3, SLOTB=8192;
constexpr int LDS_K=0, LDS_V=NSLOT*SLOTB, LDS_WS=2*NSLOT*SLOTB, LDS_OST=LDS_WS+NW*64*4, LDS_FK=LDS_OST+NW*4096, LDS_BYTES=LDS_FK+SEQ*4;
constexpr float C2=0.125f*1.4426950408889634f;
__device__ __forceinline__ void glds16(const void*gsrc,unsigned lds_dst){unsigned keep;
  asm volatile("s_mov_b32 %0, m0\n\ts_mov_b32 m0, %2\n\ts_nop 0\n\tglobal_load_lds_dwordx4 %1, off\n\ts_mov_b32 m0, %0":"=&s"(keep):"v"(gsrc),"s"(lds_dst):"memory");}
__device__ __forceinline__ float max3f(float a,float b,float c){float r;asm("v_max3_f32 %0, %1, %2, %3":"=v"(r):"v"(a),"v"(b),"v"(c));return r;}
__device__ __forceinline__ float max2f(float a,float b){float r;asm("v_max_f32_e32 %0, %1, %2":"=v"(r):"v"(a),"v"(b));return r;}
__device__ __forceinline__ float fadd_s(float a,float b){float r;asm("v_add_f32_e32 %0, %1, %2":"=v"(r):"v"(a),"v"(b));return r;}
__device__ __forceinline__ float fsub_s(float a,float b){float r;asm("v_sub_f32_e32 %0, %1, %2":"=v"(r):"v"(a),"v"(b));return r;}
typedef float f32x2_t __attribute__((ext_vector_type(2))); typedef __bf16 bf16x2_t __attribute__((ext_vector_type(2)));
__device__ __forceinline__ unsigned cvtpk_s(float lo,float hi){f32x2_t v={lo,hi};bf16x2_t b=__builtin_convertvector(v,bf16x2_t);return __builtin_bit_cast(unsigned,b);}
#define WAIT_BAR(N) asm volatile("s_waitcnt vmcnt(" #N ") lgkmcnt(0)\n\ts_barrier":::"memory")

__device__ __forceinline__ void qkt(f32x16&p0,f32x16&p1,const char*Kslot,const bf16x8*qr,int r32,int hi){
  const char*kb=Kslot+hi*1024+r32*16;
  #pragma unroll
  for(int d0=0;d0<4;++d0){
    const bf16x8 b0=*reinterpret_cast<const bf16x8*>(kb+d0*2048);
    const bf16x8 b1=*reinterpret_cast<const bf16x8*>(kb+d0*2048+512);
    p0=__builtin_amdgcn_mfma_f32_32x32x16_bf16(b0,qr[d0],p0,0,0,0);p1=__builtin_amdgcn_mfma_f32_32x32x16_bf16(b1,qr[d0],p1,0,0,0);}
}
typedef __attribute__((address_space(3))) const char* lds_cptr;
typedef short v4i16_t __attribute__((ext_vector_type(4)));
__device__ __forceinline__ void kload8(bf16x8*kf,lds_cptr kp){
  kf[0]=*(const __attribute__((address_space(3))) bf16x8*)(kp);      kf[1]=*(const __attribute__((address_space(3))) bf16x8*)(kp+512);
  kf[2]=*(const __attribute__((address_space(3))) bf16x8*)(kp+2048); kf[3]=*(const __attribute__((address_space(3))) bf16x8*)(kp+2560);
  kf[4]=*(const __attribute__((address_space(3))) bf16x8*)(kp+4096); kf[5]=*(const __attribute__((address_space(3))) bf16x8*)(kp+4608);
  kf[6]=*(const __attribute__((address_space(3))) bf16x8*)(kp+6144); kf[7]=*(const __attribute__((address_space(3))) bf16x8*)(kp+6656);
}
__device__ __forceinline__ void kload2(bf16x8*kf,lds_cptr kp,int j){ kf[2*j]=*(const __attribute__((address_space(3))) bf16x8*)(kp+j*2048); kf[2*j+1]=*(const __attribute__((address_space(3))) bf16x8*)(kp+j*2048+512); }
__device__ __forceinline__ s16x4 vtr(lds_cptr p){ return __builtin_bit_cast(s16x4,__builtin_amdgcn_ds_read_tr16_b64_v4i16((__attribute__((address_space(3))) v4i16_t*)p)); }
__device__ __forceinline__ float rowmax(const f32x16&p0,const f32x16&p1){
  float a=max3f(p0[0],p0[1],p1[0]),b=max3f(p0[2],p0[3],p1[1]);a=max3f(a,p1[2],p1[3]);
  #pragma unroll
  for(int r=4;r<16;r+=4){a=max3f(a,p0[r],p0[r+1]);b=max3f(b,p0[r+2],p0[r+3]);a=max3f(a,p1[r],p1[r+1]);b=max3f(b,p1[r+2],p1[r+3]);}
  const float m=max2f(a,b);
  auto rr=__builtin_amdgcn_permlane32_swap(__float_as_uint(m),__float_as_uint(m),false,false);
  return max2f(__uint_as_float(rr[0]),__uint_as_float(rr[1]));
}
__device__ __forceinline__ void pv(f32x16*o,int vb,bf16x8 pa0,bf16x8 pa1,bf16x8 pa2,bf16x8 pa3){
  #pragma unroll
  for(int d0=0;d0<2;++d0){s16x4 lo[4],hi[4];
    #pragma unroll
    for(int ks=0;ks<4;++ks){
      asm volatile("ds_read_b64_tr_b16 %0,%1 offset:%c2":"=&v"(lo[ks]):"v"(vb),"i"(d0*4096+ks*1024):"memory");
      asm volatile("ds_read_b64_tr_b16 %0,%1 offset:%c2":"=&v"(hi[ks]):"v"(vb),"i"(d0*4096+ks*1024+512):"memory");}
    asm volatile("s_waitcnt lgkmcnt(0)":::"memory");SBAR();
    #define PK(k) (bf16x8){lo[k][0],lo[k][1],lo[k][2],lo[k][3],hi[k][0],hi[k][1],hi[k][2],hi[k][3]}
    o[d0]=__builtin_amdgcn_mfma_f32_32x32x16_bf16(pa0,PK(0),o[d0],0,0,0);
    o[d0]=__builtin_amdgcn_mfma_f32_32x32x16_bf16(pa1,PK(1),o[d0],0,0,0);
    o[d0]=__builtin_amdgcn_mfma_f32_32x32x16_bf16(pa2,PK(2),o[d0],0,0,0);
    o[d0]=__builtin_amdgcn_mfma_f32_32x32x16_bf16(pa3,PK(3),o[d0],0,0,0);
    #undef PK
  }
}

#ifndef ATTN_STORE16
#define ATTN_STORE16(p,v) (*(u32x4*)(p)=(v))
#endif
template<int THRL> __device__ __forceinline__ void attn_unit(int b,int h,int qb,const bf16*Q,const bf16*__restrict__ K,const bf16*__restrict__ V,bf16*O,const bf16*__restrict__ Gt,const float*__restrict__ Fc,char*shm){
  int tid=threadIdx.x; asm volatile("":"+v"(tid)); const int lane=tid&63,r32=lane&31,hi=lane>>5; const int wid=__builtin_amdgcn_readfirstlane(tid>>6);
  const long rowbase=(long)b*SEQ; const int q0=qb*QB;
  const bf16*Qw=Q+(rowbase+q0+wid*QBLK)*DM+h*D;
  const bf16*Kh=K+rowbase*DM+h*D,*Vh=V+rowbase*DM+h*D;
  const unsigned lds0=(unsigned)(uintptr_t)shm;
  float*wsf=(float*)(shm+LDS_WS)+wid*64;
  const bf16*ksrc=Kh+(long)lane*DM+wid*8;
  const bf16*vsrc=Vh+(long)(16*(wid&3)+(lane>>2))*DM+(wid>>2)*32+(lane&3)*8;
  const unsigned kdst=lds0+LDS_K+wid*1024, vdst=lds0+LDS_V+wid*1024;
  #define DMA_K(t,slot) glds16(ksrc+(long)(t)*KVBLK*DM,(unsigned)__builtin_amdgcn_readfirstlane(kdst+(slot)))
  #define DMA_V(t,slot) glds16(vsrc+(long)(t)*KVBLK*DM,(unsigned)__builtin_amdgcn_readfirstlane(vdst+(slot)))
  const int vb0=(int)(lds0+LDS_V)+((lane>>4)&1)*32+(lane&3)*8+(4*hi+((lane&15)>>2))*64;
  const char*Kbase=shm+LDS_K; bf16x8 kf[8];
  const lds_cptr shm3=(lds_cptr)shm; const lds_cptr kp0=shm3+LDS_K+hi*1024+r32*16; const lds_cptr vp0=shm3+LDS_V+((lane>>4)&1)*32+(lane&3)*8+(4*hi+((lane&15)>>2))*64;
  const int NT=(q0+QB)/KVBLK;
  { f32x4*fkw=(f32x4*)(shm+LDS_FK); const int n4=(q0+QB)>>2; for(int i=tid;i<n4;i+=NW*64)fkw[i]=((const f32x4*)Fc)[i]; }
  float fqm=Fc[q0+wid*QBLK+r32];
  asm volatile("s_waitcnt vmcnt(0) lgkmcnt(0)\n\ts_barrier":::"memory");
  typedef __attribute__((address_space(3))) const f32x4* lds_f4ptr;
  const lds_cptr fk0=(lds_cptr)shm+LDS_FK+hi*16;
  #define CINIT(C0,C1,t) do{ const lds_cptr fp_=fk0+(t)*256; \
    _Pragma("unroll") for(int g_=0;g_<4;++g_){ const f32x4 a_=*(lds_f4ptr)(fp_+g_*32); const f32x4 b_=*(lds_f4ptr)(fp_+128+g_*32); \
      _Pragma("unroll") for(int e_=0;e_<4;++e_){ C0[g_*4+e_]=fqm-a_[e_]; C1[g_*4+e_]=fqm-b_[e_]; } } }while(0)
  DMA_K(0,0);DMA_V(0,0);DMA_K(1,SLOTB);
  bf16x8 qr[4];
  #pragma unroll
  for(int d0=0;d0<4;++d0)qr[d0]=*reinterpret_cast<const bf16x8*>(&Qw[(long)r32*DM+d0*16+hi*8]);
  float l_reg=0.f;f32x16 o[2];o[0]=f32x16{};o[1]=f32x16{};
  const int qrel=wid*QBLK+r32;
  #define CMASK(P0,P1,t) do{int jb_=(t)-(NT-4); if(jb_>=0)cmask(P0,P1,jb_,qrel,hi);}while(0)
  bool resc=false;
  #define START(P0,P1) do{ const float rm=rowmax(P0,P1); resc=false; \
    { const float dl=rm; fqm=fsub_s(fqm,dl); \
      _Pragma("unroll") for(int r=0;r<16;++r){P0[r]=fsub_s(P0[r],dl);P1[r]=fsub_s(P1[r],dl);} } \
    _Pragma("unroll") for(int r=0;r<16;++r)P0[r]=__builtin_amdgcn_exp2f(P0[r]); }while(0)
  #define RESC() do{ if(resc){ asm volatile("s_waitcnt lgkmcnt(0)":::"memory"); \
      _Pragma("unroll") for(int d_=0;d_<2;++d_) _Pragma("unroll") for(int r=0;r<16;++r)o[d_][r]*=wsf[crow(r,hi)]; } }while(0)
  f32x16 pA0,pA1,pB0,pB1;
  int sl_prev=0,sl_cur=0,sl_next=SLOTB;
  #define ROT() do{sl_prev=sl_cur;sl_cur=sl_next;sl_next=(sl_next==(NSLOT-1)*SLOTB)?0:sl_next+SLOTB;}while(0)
  DMA_K(2,2*SLOTB);
  WAIT_BAR(3);
  CINIT(pA0,pA1,0); qkt(pA0,pA1,Kbase,qr,r32,hi);asm volatile("s_nop 15\n\ts_nop 7":"+v"(pA0),"+v"(pA1));CMASK(pA0,pA1,0);
  START(pA0,pA1);
  _Pragma("unroll") for(int r=0;r<16;++r)pA1[r]=__builtin_amdgcn_exp2f(pA1[r]);
  WAIT_BAR(0);
  DMA_K(3,0);DMA_V(1,SLOTB);
  ROT();
  kload8(kf,kp0+sl_cur);
  WAIT_BAR(2);
  s16x4 vlo[8],vhi[8]; u32x4 pw0,pw1,pw2,pw3;
  #define PKW(P,B) cvtpk_s(P[B],P[B+1])
  #define PAF(k) __builtin_bit_cast(bf16x8,pw##k)
  #define VFR(i) (bf16x8){vlo[i][0],vlo[i][1],vlo[i][2],vlo[i][3],vhi[i][0],vhi[i][1],vhi[i][2],vhi[i][3]}
  #define PIN(x) asm volatile("":"+v"(x))
  #define MX3(a,b,c) __builtin_fmaxf(__builtin_fmaxf((a),(b)),(c))
  #define GAPA(MF,A0,A1,A2,A3,W0,W1,PW) do{ MF; sacc+=A0; sacc+=A1; sacc+=A2; sacc+=A3; PIN(sacc); W0; W1; PIN(PW); SBAR(); }while(0)
  #define EX(v) __builtin_amdgcn_exp2f(v)
  #define GAPB(MF,X,B) do{ MF; X[B]=EX(X[B]); X[B+1]=EX(X[B+1]); X[B+2]=EX(X[B+2]); X[B+3]=EX(X[B+3]); PIN(X); SBAR(); }while(0)
  #define VRD(i) do{ vlo[i]=vtr(vp_+(((i)>>2)*4096+((i)&3)*1024)); vhi[i]=vtr(vp_+(((i)>>2)*4096+((i)&3)*1024+512)); }while(0)
  #define KRD(G,j) do{ if(G){ kload2(kf,kp0+sl_next,j); SBAR(); } }while(0)
  #define STEP(C0,C1,P0,P1,t,GK,GV,GL) do{ SBAR(); CINIT(C0,C1,t); SBAR(); \
    const lds_cptr vp_=vp0+sl_prev; \
    VRD(0); SBAR(); float sacc=(P0[0]+P0[1]); \
    GAPA(C0=__builtin_amdgcn_mfma_f32_32x32x16_bf16(kf[0],qr[0],C0,0,0,0), P0[2],P0[3],P0[4],P0[5],     pw0[0]=PKW(P0,0), pw0[1]=PKW(P0,2), pw0); \
    VRD(4); SBAR(); GAPA(C1=__builtin_amdgcn_mfma_f32_32x32x16_bf16(kf[1],qr[0],C1,0,0,0), P0[6],P0[7],P0[8],P0[9],     pw0[2]=PKW(P0,4), pw0[3]=PKW(P0,6), pw0); \
    VRD(1); SBAR(); GAPA(C0=__builtin_amdgcn_mfma_f32_32x32x16_bf16(kf[2],qr[1],C0,0,0,0),   P0[10],P0[11],P0[12],P0[13], pw1[0]=PKW(P0,8), pw1[1]=PKW(P0,10), pw1); \
    VRD(5); SBAR(); GAPA(C1=__builtin_amdgcn_mfma_f32_32x32x16_bf16(kf[3],qr[1],C1,0,0,0),   P0[14],P0[15],P1[0],P1[1],   pw1[2]=PKW(P0,12),pw1[3]=PKW(P0,14), pw1); \
    VRD(2); SBAR(); GAPA(C0=__builtin_amdgcn_mfma_f32_32x32x16_bf16(kf[4],qr[2],C0,0,0,0),   P1[2],P1[3],P1[4],P1[5],     pw2[0]=PKW(P1,0), pw2[1]=PKW(P1,2), pw2); \
    VRD(6); SBAR(); GAPA(C1=__builtin_amdgcn_mfma_f32_32x32x16_bf16(kf[5],qr[2],C1,0,0,0),   P1[6],P1[7],P1[8],P1[9],     pw2[2]=PKW(P1,4), pw2[3]=PKW(P1,6), pw2); \
    VRD(3); SBAR(); GAPA(C0=__builtin_amdgcn_mfma_f32_32x32x16_bf16(kf[6],qr[3],C0,0,0,0),   P1[10],P1[11],P1[12],P1[13], pw3[0]=PKW(P1,8), pw3[1]=PKW(P1,10), pw3); \
    VRD(7); SBAR(); GAPA(C1=__builtin_amdgcn_mfma_f32_32x32x16_bf16(kf[7],qr[3],C1,0,0,0),   P1[14],P1[15],0.f,0.f,       pw3[2]=PKW(P1,12),pw3[3]=PKW(P1,14), pw3); \
    l_reg+=sacc; \
    if(GK){DMA_K((t)+3,sl_cur);} if(GV){DMA_V((t)+1,sl_next);} \
    CMASK(C0,C1,t); \
    { float a=MX3(C0[0],C0[1],C1[0]),b=MX3(C0[2],C0[3],C1[1]); a=MX3(a,C1[2],C1[3]); \
      _Pragma("unroll") for(int r=4;r<16;r+=4){a=MX3(a,C0[r],C0[r+1]);b=MX3(b,C0[r+2],C0[r+3]);a=MX3(a,C1[r],C1[r+1]);b=MX3(b,C1[r+2],C1[r+3]);} \
      float rm=__builtin_fmaxf(a,b); { auto rr=__builtin_amdgcn_permlane32_swap(__float_as_uint(rm),__float_as_uint(rm),false,false); rm=__builtin_fmaxf(__uint_as_float(rr[0]),__uint_as_float(rr[1])); } \
      resc=false; \
      if(__builtin_expect(__any(rm>(float)THRL),0)){ const float dl=__builtin_fmaxf(rm,0.f); fqm-=dl; \
        _Pragma("unroll") for(int r=0;r<16;++r){C0[r]-=dl;C1[r]-=dl;} \
        const float f=__builtin_amdgcn_exp2f(-dl); l_reg*=f; if(hi==0)wsf[r32]=f; resc=true; } } \
    SBAR(); \
    GAPB(o[0]=__builtin_amdgcn_mfma_f32_32x32x16_bf16(PAF(0),VFR(0),o[0],0,0,0), C0,0); \
    GAPB(o[1]=__builtin_amdgcn_mfma_f32_32x32x16_bf16(PAF(0),VFR(4),o[1],0,0,0), C0,4); \
    KRD(GL,0); GAPB(o[0]=__builtin_amdgcn_mfma_f32_32x32x16_bf16(PAF(1),VFR(1),o[0],0,0,0), C0,8); \
    KRD(GL,1); GAPB(o[1]=__builtin_amdgcn_mfma_f32_32x32x16_bf16(PAF(1),VFR(5),o[1],0,0,0), C0,12); \
    KRD(GL,2); GAPB(o[0]=__builtin_amdgcn_mfma_f32_32x32x16_bf16(PAF(2),VFR(2),o[0],0,0,0), C1,0); \
    KRD(GL,3); GAPB(o[1]=__builtin_amdgcn_mfma_f32_32x32x16_bf16(PAF(2),VFR(6),o[1],0,0,0), C1,4); \
    GAPB(o[0]=__builtin_amdgcn_mfma_f32_32x32x16_bf16(PAF(3),VFR(3),o[0],0,0,0), C1,8); \
    GAPB(o[1]=__builtin_amdgcn_mfma_f32_32x32x16_bf16(PAF(3),VFR(7),o[1],0,0,0), C1,12); \
    }while(0)
  int t=1;
  #undef CMASK
  #define CMASK(P0,P1,t) do{}while(0)
  for(;t+5<NT;t+=2){
    STEP(pB0,pB1,pA0,pA1,t,true,true,true);     WAIT_BAR(2); RESC(); ROT();
    STEP(pA0,pA1,pB0,pB1,t+1,true,true,true);   WAIT_BAR(2); RESC(); ROT();
  }
  #undef CMASK
  #define CMASK(P0,P1,t) do{int jb_=(t)-(NT-4); if(jb_>=0)cmask(P0,P1,jb_,qrel,hi);}while(0)
  #define ENDW(tt) do{ if((tt)+3<NT){WAIT_BAR(2);} else if((tt)+2<NT){WAIT_BAR(1);} else {WAIT_BAR(0);} }while(0)
  for(;t+1<NT;t+=2){
    STEP(pB0,pB1,pA0,pA1,t,(t+3<NT),(t+1<NT),(t+1<NT));       ENDW(t);   RESC(); ROT();
    STEP(pA0,pA1,pB0,pB1,t+1,(t+4<NT),(t+2<NT),(t+2<NT));     ENDW(t+1); RESC(); ROT();
  }
  STEP(pB0,pB1,pA0,pA1,NT-1,false,false,false); RESC();
  { float sacc=pB0[0]+pB0[1]; _Pragma("unroll") for(int r=2;r<16;++r)sacc+=pB0[r]; _Pragma("unroll") for(int r=0;r<16;++r)sacc+=pB1[r]; l_reg+=sacc;
    pw0=(u32x4){PKW(pB0,0),PKW(pB0,2),PKW(pB0,4),PKW(pB0,6)};pw1=(u32x4){PKW(pB0,8),PKW(pB0,10),PKW(pB0,12),PKW(pB0,14)};pw2=(u32x4){PKW(pB1,0),PKW(pB1,2),PKW(pB1,4),PKW(pB1,6)};pw3=(u32x4){PKW(pB1,8),PKW(pB1,10),PKW(pB1,12),PKW(pB1,14)};
    SBAR(); pv(o,vb0+sl_cur,PAF(0),PAF(1),PAF(2),PAF(3)); }
  #undef PKW
  #undef PAF
  #undef VFR
  #undef PIN
  #undef MX3
  #undef GAPA
  #undef GAPB
  #undef EX
  #undef VRD
  #undef KRD
  #undef STEP
  #undef ENDW
  {auto rr=__builtin_amdgcn_permlane32_swap(__float_as_uint(l_reg),__float_as_uint(l_reg),false,false);l_reg=__uint_as_float(rr[0])+__uint_as_float(rr[1]);}
  if(hi==0)wsf[32+r32]=l_reg;asm volatile("s_waitcnt lgkmcnt(0)":::"memory");
  float rli[16];
  #pragma unroll
  for(int r=0;r<16;++r)rli[r]=__builtin_amdgcn_rcpf(wsf[32+crow(r,hi)]);
  bf16*Ow=O+(rowbase+q0+wid*QBLK)*ODM+h*D; const bf16*Gw=Gt+(rowbase+q0+wid*QBLK)*DM+h*D;
  { bf16*stg=(bf16*)(shm+LDS_OST)+wid*2048;
    #pragma unroll
    for(int r=0;r<16;++r){const int orow=crow(r,hi);
      #pragma unroll
      for(int d0=0;d0<2;++d0)stg[orow*64+d0*32+r32]=__float2bfloat16(o[d0][r]*rli[r]);}
    asm volatile("s_waitcnt lgkmcnt(0)":::"memory");
    #pragma unroll
    for(int i=0;i<4;++i){const int row=i*8+(lane>>3),ch=lane&7; u32x4 v=*(const u32x4*)(stg+row*64+ch*8); const u32x4 g=*(const u32x4*)(Gw+(long)row*DM+ch*8);
      #pragma unroll
      for(int e=0;e<4;++e)v[e]=cvtpk_s(__uint_as_float(v[e]<<16)*__uint_as_float(g[e]<<16),__uint_as_float(v[e]&0xffff0000u)*__uint_as_float(g[e]&0xffff0000u));
      ATTN_STORE16(Ow+(long)row*ODM+ch*8,v);} }
  asm volatile("s_waitcnt lgkmcnt(0)\n\ts_barrier":::"memory");
  #undef CINIT
  #undef DMA_K
  #undef DMA_V
  #undef CMASK
  #undef START
  #undef RESC
  #undef ROT
}
constexpr int ATTN_LDS_BYTES=LDS_BYTES;
#undef SBAR
#undef WAIT_BAR
}

__device__ __forceinline__ void p0_mod_item(int item, const Params& p, float* MOD, float* lds) {
    int tid = threadIdx.x; asm volatile("" : "+v"(tid));
    const int l = item / 48, n0 = (item % 48) * 64;
    float* sc = lds;
    float* red = lds + 4096;
    for (int i = tid; i < 4096; i += NTHREADS) sc[i] = silu_f(p.c[i]);
    __syncthreads();
    const int nl = tid & 63, ks = tid >> 6;
    float a0 = 0.f, a1 = 0.f, a2 = 0.f, a3 = 0.f;
    const float* w = p.ada_w + ((size_t)l * 1024 + ks * 128) * 3072 + n0 + nl;
#pragma unroll 8
    for (int k = 0; k < 128; ++k) {
        const float wv = w[(size_t)k * 3072]; const int kk = ks * 128 + k;
        a0 += sc[kk] * wv; a1 += sc[1024 + kk] * wv; a2 += sc[2048 + kk] * wv; a3 += sc[3072 + kk] * wv;
    }
    red[(ks * 4 + 0) * 64 + nl] = a0; red[(ks * 4 + 1) * 64 + nl] = a1; red[(ks * 4 + 2) * 64 + nl] = a2; red[(ks * 4 + 3) * 64 + nl] = a3;
    __syncthreads();
    if (tid < 256) {
        const int b = tid >> 6; float s = p.ada_b[l * 3072 + n0 + nl];
#pragma unroll
        for (int k = 0; k < 8; ++k) s += red[(k * 4 + b) * 64 + nl];
        MOD[(size_t)(l * 4 + b) * 3072 + n0 + nl] = s;
    }
    __syncthreads();
}
__device__ __forceinline__ void p0_tr_item(const float* W, int ldn, int k0, int csrc0, bf16_t* WT, int n0, float* tile) {
    int tid = threadIdx.x; asm volatile("" : "+v"(tid));
    {
        const int r = tid >> 6, cc = tid & 63;
#pragma unroll
        for (int i = 0; i < 8; ++i) { const int k = r + 8 * i; tile[k * 65 + cc] = W[(size_t)(k0 + k) * ldn + csrc0 + cc]; }
    }
    __syncthreads();
    {
        const int n = tid >> 3, kc = tid & 7;
        const float* s = tile + (kc * 8) * 65 + n;
        uint4 o; o.x = pk2(s[0], s[65]); o.y = pk2(s[2 * 65], s[3 * 65]); o.z = pk2(s[4 * 65], s[5 * 65]); o.w = pk2(s[6 * 65], s[7 * 65]);
        *(uint4*)(WT + (size_t)(n0 + n) * 1024 + k0 + kc * 8) = o;
    }
    __syncthreads();
}
__device__ __forceinline__ void p0_prologue(const Params& p, float* lds) {
    unsigned char* ws = p.ws;
    float* MOD = (float*)(ws + WS_MOD);
    const int G = gridDim.x, blk = blockIdx.x; int tid = threadIdx.x; asm volatile("" : "+v"(tid));
    constexpr int N_MOD = 96, N_WIN = 2 * 16 * 52, N_WOUT = 2 * 16 * 16;
    for (int it = blk; it < N_MOD + N_WIN + N_WOUT; it += G) {
        if (it < N_MOD) { p0_mod_item(it, p, MOD, lds); continue; }
        int r = it - N_MOD;
        if (r < N_WIN) {
            const int l = r / (16 * 52), q = r % (16 * 52), kb = q / 52, nb = q % 52;
            const int n0 = nb * 64, csrc0 = n0 + (n0 >= FCOL ? 8 : 0);
            p0_tr_item(p.w_in + (size_t)l * 1024 * DIN, DIN, kb * 64, csrc0, (bf16_t*)(ws + WS_WINT + l * WS_WINT_STRIDE), n0, lds);
            continue;
        }
        r -= N_WIN;
        { const int l = r / 256, q = r % 256, kb = q / 16, nb = q % 16;
          p0_tr_item(p.w_out + (size_t)l * 1024 * 1024, 1024, kb * 64, nb * 64, (bf16_t*)(ws + WS_WOUTT + (size_t)l * 2 * MiB), nb * 64, lds); }
    }
    const int gt = blk * NTHREADS + tid, GT = G * NTHREADS;
    bf16_t* SGW = (bf16_t*)(ws + WS_SGW);
    for (int i = gt; i < 2 * 4 * 128 * 128; i += GT) { const int s = i & 127, t = (i >> 7) & 127; SGW[i] = (bf16_t)(s <= t ? f2bf(p.sg_w[i]) : 0u); }
    bf16_t* WAT = (bf16_t*)(ws + WS_WAT);
    for (int i = gt; i < 2 * 2 * 4 * 64 * 64; i += GT) {
        const int ii = i & 63, j = (i >> 6) & 63, g = (i >> 12) & 3, mat = (i >> 14) & 1, l = i >> 15;
        const float* src = mat ? p.lru_wx : p.lru_wa;
        WAT[i] = (bf16_t)f2bf(src[((size_t)(l * 4 + g) * 64 + ii) * 64 + j]);
    }
}

template <bool FIRST, bool NEXT>
__device__ __forceinline__ void row_pass(const Params& p, int lprev, int ln, const float* xres, float* xout, float* lds) {
    unsigned char* ws = p.ws;
    int tid = threadIdx.x; asm volatile("" : "+v"(tid)); const int lane = tid & 63, wave = tid >> 6;
    const float* MOD = (const float*)(ws + WS_MOD);
    const bf16_t* YOUT = (const bf16_t*)(ws + WS_YOUT);
    bf16_t* H = (bf16_t*)(ws + WS_H);
    float* LS = (float*)(ws + WS_LS);
    float* wfl = lds;
    if (NEXT) {
        for (int i = tid; i < 8192; i += NTHREADS) { const int cc = i >> 3, jj = i & 7; wfl[jj * 1024 + cc] = p.w_in[((size_t)ln * 1024 + cc) * DIN + FCOL + jj]; }
        __syncthreads();
    }
    const int gw = blockIdx.x * 8 + wave, NGW = gridDim.x * 8;
    for (int row = gw; row < MROWS; row += NGW) {
        const int b = row >> 12;
        f32x4 xv[4];
#pragma unroll
        for (int j = 0; j < 4; ++j) xv[j] = *(const f32x4*)(xres + (size_t)row * DM + j * 256 + lane * 4);
        if (!FIRST) {
            f32x4 yv[4]; float ss = 0.f;
#pragma unroll
            for (int j = 0; j < 4; ++j) {
                const uint2 w = *(const uint2*)(YOUT + (size_t)row * DM + j * 256 + lane * 4);
                yv[j] = (f32x4){bflo(w.x), bfhi(w.x), bflo(w.y), bfhi(w.y)};
                ss += (yv[j].x * yv[j].x + yv[j].y * yv[j].y) + (yv[j].z * yv[j].z + yv[j].w * yv[j].w);
            }
            const float rinv = rsqrtf(wave_sum(ss) * (1.f / DM) + EPS);
            const float* gate = MOD + (size_t)(lprev * 4 + b) * 3072 + 2048;
#pragma unroll
            for (int j = 0; j < 4; ++j) {
                const f32x4 pg = *(const f32x4*)(p.post_g + lprev * DM + j * 256 + lane * 4);
                const f32x4 gt = *(const f32x4*)(gate + j * 256 + lane * 4);
                xv[j] = xv[j] + gt * ((yv[j] * rinv) * pg);
                *(f32x4*)(xout + (size_t)row * DM + j * 256 + lane * 4) = xv[j];
            }
        }
        if (NEXT) {
            float ss = 0.f;
#pragma unroll
            for (int j = 0; j < 4; ++j) ss += (xv[j].x * xv[j].x + xv[j].y * xv[j].y) + (xv[j].z * xv[j].z + xv[j].w * xv[j].w);
            const float rinv = rsqrtf(wave_sum(ss) * (1.f / DM) + EPS);
            const float* shift = MOD + (size_t)(ln * 4 + b) * 3072;
            const float* scale = shift + 1024;
            float fl[8];
#pragma unroll
            for (int jj = 0; jj < 8; ++jj) fl[jj] = 0.f;
#pragma unroll
            for (int j = 0; j < 4; ++j) {
                const int c0 = j * 256 + lane * 4;
                const f32x4 pg = *(const f32x4*)(p.pre_g + ln * DM + c0);
                const f32x4 sh = *(const f32x4*)(shift + c0);
                const f32x4 sc = *(const f32x4*)(scale + c0);
                const f32x4 hv = ((xv[j] * rinv) * pg) * (sc + 1.0f) + sh;
                uint2 o; o.x = pk2(hv.x, hv.y); o.y = pk2(hv.z, hv.w);
                *(uint2*)(H + (size_t)row * DM + c0) = o;
#pragma unroll
                for (int jj = 0; jj < 8; ++jj) { const f32x4 wv = *(const f32x4*)(wfl + jj * 1024 + c0); fl[jj] += (hv.x * wv.x + hv.y * wv.y) + (hv.z * wv.z + hv.w * wv.w); }
                asm volatile("" ::: "memory");
            }
#pragma unroll
            for (int jj = 0; jj < 8; ++jj) fl[jj] = wave_sum(fl[jj]);
            float mine = fl[0];
#pragma unroll
            for (int jj = 1; jj < 8; ++jj) mine = (lane == jj) ? fl[jj] : mine;
            if (lane < 8) {
                const float z = mine + p.b_f[ln * 8 + lane];
                const float lsg = fminf(z, 0.f) - log1pf(__expf(-fabsf(z)));
                LS[(size_t)row * 8 + lane] = lsg * LOG2E;
            }
        }
    }
    __syncthreads();
}

template <class Store>
__device__ __forceinline__ void gemm_naive(const bf16_t* A, const bf16_t* Bt, int N, float* lds, const Store& st) {
    float* As = lds; float* Bs = lds + 32 * 68;
    int tid = threadIdx.x; asm volatile("" : "+v"(tid)); const int ntn = N / 64, ntiles = (MROWS / 64) * ntn;
    const int r = tid >> 3, kq = tid & 7, ty = tid >> 4, tx = tid & 15;
    for (int tile = blockIdx.x; tile < ntiles; tile += gridDim.x) {
        const int tm = tile / ntn, tn = tile % ntn;
        float acc[2][4];
#pragma unroll
        for (int i = 0; i < 2; ++i)
#pragma unroll
            for (int j = 0; j < 4; ++j) acc[i][j] = 0.f;
        for (int k0 = 0; k0 < 1024; k0 += 32) {
            const uint2 av = *(const uint2*)(A + (size_t)(tm * 64 + r) * 1024 + k0 + kq * 4);
            const uint2 bv = *(const uint2*)(Bt + (size_t)(tn * 64 + r) * 1024 + k0 + kq * 4);
            As[(kq * 4 + 0) * 68 + r] = bflo(av.x); As[(kq * 4 + 1) * 68 + r] = bfhi(av.x); As[(kq * 4 + 2) * 68 + r] = bflo(av.y); As[(kq * 4 + 3) * 68 + r] = bfhi(av.y);
            Bs[(kq * 4 + 0) * 68 + r] = bflo(bv.x); Bs[(kq * 4 + 1) * 68 + r] = bfhi(bv.x); Bs[(kq * 4 + 2) * 68 + r] = bflo(bv.y); Bs[(kq * 4 + 3) * 68 + r] = bfhi(bv.y);
            __syncthreads();
#pragma unroll 8
            for (int k = 0; k < 32; ++k) {
                const float2 a = *(const float2*)&As[k * 68 + ty * 2];
                const float4 bq = *(const float4*)&Bs[k * 68 + tx * 4];
                acc[0][0] += a.x * bq.x; acc[0][1] += a.x * bq.y; acc[0][2] += a.x * bq.z; acc[0][3] += a.x * bq.w;
                acc[1][0] += a.y * bq.x; acc[1][1] += a.y * bq.y; acc[1][2] += a.y * bq.z; acc[1][3] += a.y * bq.w;
            }
            __syncthreads();
        }
#pragma unroll
        for (int i = 0; i < 2; ++i)
#pragma unroll
            for (int j = 0; j < 4; ++j) st(tm * 64 + ty * 2 + i, tn * 64 + tx * 4 + j, acc[i][j]);
    }
}
struct StoreProj { ProjOut P; __device__ __forceinline__ void operator()(int row, int n, float v) const { proj_store(P, row, n, v); } };
struct StoreBf16 { bf16_t* O; int ld; __device__ __forceinline__ void operator()(int row, int n, float v) const { O[(size_t)row * ld + n] = (bf16_t)f2bf(v); } };

__device__ __forceinline__ void fcum_item(int bh, const float* LS, float* FC, float* lds) {
    int tid = threadIdx.x; asm volatile("" : "+v"(tid)); const int b = bh >> 3, h = bh & 7;
    float v[8]; float run = 0.f;
#pragma unroll
    for (int i = 0; i < 8; ++i) { run += LS[((size_t)b * SEQ + tid * 8 + i) * 8 + h]; v[i] = run; }
    float* s0 = lds; float* s1 = lds + 512;
    s0[tid] = run;
    __syncthreads();
    float* src = s0; float* dst = s1;
    for (int off = 1; off < 512; off <<= 1) {
        float t = src[tid]; if (tid >= off) t += src[tid - off];
        dst[tid] = t;
        __syncthreads();
        float* tmp = src; src = dst; dst = tmp;
    }
    const float excl = src[tid] - run;
#pragma unroll
    for (int i = 0; i < 8; ++i) FC[(size_t)bh * SEQ + tid * 8 + i] = v[i] + excl;
    __syncthreads();
}

template <int MODE>
__device__ __forceinline__ void lru_item(int item, int layer, const Params& p, unsigned char* ldsb) {
    unsigned char* ws = p.ws;
    int tid = threadIdx.x; asm volatile("" : "+v"(tid)); const int lane = tid & 63, wave = tid >> 6;
    const int b = item >> 7, c = item & 127, t0 = c * 32; const size_t r0 = (size_t)b * SEQ + t0;
    const bf16_t* XLRU = (const bf16_t*)(ws + WS_XLRU);
    const bf16_t* GLRU = (const bf16_t*)(ws + WS_GLRU);
    const bf16_t* WAT = (const bf16_t*)(ws + WS_WAT);
    float* AGG = (float*)(ws + WS_AGG);
    bf16_t* Y = (bf16_t*)(ws + WS_Y);
    bf16_t* xcb = (bf16_t*)ldsb;
    float* aL = (float*)(ldsb + 32 * 264 * 2);
    float* bL = aL + 32 * 256;
    float* ex = bL + 32 * 256;
    {
        const int ch = (tid & 127) * 2, tq = tid >> 7;
        float w0[4], w1[4];
#pragma unroll
        for (int k = 0; k < 4; ++k) { w0[k] = p.conv_w[(layer * 4 + k) * 256 + ch]; w1[k] = p.conv_w[(layer * 4 + k) * 256 + ch + 1]; }
        const float cb0 = p.conv_b[layer * 256 + ch], cb1 = p.conv_b[layer * 256 + ch + 1];
        float xa[11], xb[11];
#pragma unroll
        for (int i = 0; i < 11; ++i) {
            const int t = t0 + tq * 8 - 3 + i;
            unsigned w = 0u;
            if (t >= 0) w = *(const unsigned*)(XLRU + ((size_t)b * SEQ + t) * 256 + ch);
            xa[i] = bflo(w); xb[i] = bfhi(w);
        }
#pragma unroll
        for (int i = 0; i < 8; ++i) {
            const float y0 = cb0 + w0[0] * xa[i] + w0[1] * xa[i + 1] + w0[2] * xa[i + 2] + w0[3] * xa[i + 3];
            const float y1 = cb1 + w1[0] * xb[i] + w1[1] * xb[i + 1] + w1[2] * xb[i + 2] + w1[3] * xb[i + 3];
            *(unsigned*)(xcb + (tq * 8 + i) * 264 + ch) = pk2(y0, y1);
        }
    }
    __syncthreads();
    {
        const int g = wave >> 1, jh = wave & 1, l31 = lane & 31, hi = lane >> 5;
        const int j = jh * 32 + l31, ch = g * 64 + j;
        f32x16 accR = {}, accI = {};
#pragma unroll
        for (int kb = 0; kb < 4; ++kb) {
            const bf16x8 af = *(const bf16x8*)(xcb + l31 * 264 + g * 64 + kb * 16 + hi * 8);
            const bf16x8 br = *(const bf16x8*)(WAT + ((size_t)((layer * 2 + 0) * 4 + g) * 64 + j) * 64 + kb * 16 + hi * 8);
            const bf16x8 bi = *(const bf16x8*)(WAT + ((size_t)((layer * 2 + 1) * 4 + g) * 64 + j) * 64 + kb * 16 + hi * 8);
            accR = __builtin_amdgcn_mfma_f32_32x32x16_bf16(af, br, accR, 0, 0, 0);
            accI = __builtin_amdgcn_mfma_f32_32x32x16_bf16(af, bi, accI, 0, 0, 0);
        }
        const float ba = p.lru_ba[layer * 256 + ch], bx = p.lru_bx[layer * 256 + ch], lam = p.lru_lambda[layer * 256 + ch];
        const float sp = fmaxf(-lam, 0.f) + log1pf(__expf(-fabsf(lam)));
#pragma unroll
        for (int r = 0; r < 16; ++r) {
            const int t = crow(r, hi);
            const float rg = sigmoid_f(accR[r] + ba), ig = sigmoid_f(accI[r] + bx);
            const float log_a = -8.0f * rg * sp;
            const float a = __expf(log_a);
            const float xc = bf2f(xcb[t * 264 + ch]);
            const float bt = sqrtf(fmaxf(-expm1f(2.0f * log_a), 0.f)) * (ig * xc);
            aL[t * 256 + ch] = a; bL[t * 256 + ch] = bt;
            if ((r & 3) == 3) asm volatile("" ::: "memory");
        }
    }
    __syncthreads();
    {
        const int ch = tid & 255, half = tid >> 8;
        float hl[16], ca[16]; float hloc = 0.f, cum = 1.f;
#pragma unroll
        for (int i = 0; i < 16; ++i) { const int t = half * 16 + i; const float a = aL[t * 256 + ch], bt = bL[t * 256 + ch]; hloc = a * hloc + bt; cum *= a; hl[i] = hloc; ca[i] = cum; }
        ex[(half * 2 + 0) * 256 + ch] = cum; ex[(half * 2 + 1) * 256 + ch] = hloc;
        __syncthreads();
        if (MODE == 0) {
            if (half == 0) {
                const float A1 = ex[(2 + 0) * 256 + ch], H1 = ex[(2 + 1) * 256 + ch];
                AGG[((size_t)(b * 128 + c) * 2 + 0) * 256 + ch] = cum * A1;
                AGG[((size_t)(b * 128 + c) * 2 + 1) * 256 + ch] = A1 * hloc + H1;
            }
        } else {
            float carry = 0.f;
            for (int cc = 0; cc < c; ++cc) {
                const float Ac = AGG[((size_t)(b * 128 + cc) * 2 + 0) * 256 + ch], Hc = AGG[((size_t)(b * 128 + cc) * 2 + 1) * 256 + ch];
                carry = Ac * carry + Hc;
            }
            if (half == 1) carry = ex[0 * 256 + ch] * carry + ex[1 * 256 + ch];
#pragma unroll
            for (int i = 0; i < 16; ++i) {
                const int t = half * 16 + i; const size_t row = r0 + t;
                const float hv = hl[i] + ca[i] * carry;
                const float gs = bf2f(GLRU[row * 256 + ch]);
                Y[row * 1024 + 512 + ch] = (bf16_t)f2bf(hv * gs);
                if ((i & 3) == 3) asm volatile("" ::: "memory");
            }
        }
    }
    __syncthreads();
}

__device__ __forceinline__ void sg_item(int item, int layer, const Params& p, unsigned char* ldsb) {
    unsigned char* ws = p.ws;
    int tid = threadIdx.x; asm volatile("" : "+v"(tid)); const int lane = tid & 63, wave = tid >> 6;
    const size_t r0 = (size_t)item * 128;
    const bf16_t* SGU = (const bf16_t*)(ws + WS_SGU);
    const bf16_t* SGV = (const bf16_t*)(ws + WS_SGV);
    const bf16_t* GSG = (const bf16_t*)(ws + WS_GSG);
    const bf16_t* SGW = (const bf16_t*)(ws + WS_SGW);
    bf16_t* Y = (bf16_t*)(ws + WS_Y);
    bf16_t* vn = (bf16_t*)ldsb;
    {
        const f32x4 lg = *(const f32x4*)(p.sg_ln_g + layer * 256 + lane * 4), lb = *(const f32x4*)(p.sg_ln_b + layer * 256 + lane * 4);
        for (int i = 0; i < 16; ++i) {
            const int t = wave * 16 + i;
            const uint2 w = *(const uint2*)(SGV + (r0 + t) * 256 + lane * 4);
            f32x4 v = (f32x4){bflo(w.x), bfhi(w.x), bflo(w.y), bfhi(w.y)};
            const float mu = wave_sum((v.x + v.y) + (v.z + v.w)) * (1.f / 256.f);
            v = v - mu;
            const float var = wave_sum((v.x * v.x + v.y * v.y) + (v.z * v.z + v.w * v.w)) * (1.f / 256.f);
            const float rs = rsqrtf(var + EPS);
            v = (v * rs) * lg + lb;
            uint2 o; o.x = pk2(v.x, v.y); o.y = pk2(v.z, v.w);
            *(uint2*)(vn + t * 260 + lane * 4) = o;
        }
    }
    __syncthreads();
    {
        const int g = wave >> 1, dh = wave & 1, l31 = lane & 31, hi = lane >> 5;
        const int ch = g * 64 + dh * 32 + l31;
        f32x16 acc[4];
#pragma unroll
        for (int tt = 0; tt < 4; ++tt) acc[tt] = (f32x16){};
        const bf16_t* Wg = SGW + (size_t)(layer * 4 + g) * 128 * 128;
#pragma unroll
        for (int kb = 0; kb < 8; ++kb) {
            bf16x8 bfr;
#pragma unroll
            for (int i = 0; i < 8; ++i) bfr[i] = (short)vn[(kb * 16 + hi * 8 + i) * 260 + ch];
#pragma unroll
            for (int tt = 0; tt < 4; ++tt) {
                if (tt >= (kb >> 1)) {
                    const bf16x8 af = *(const bf16x8*)(Wg + (size_t)(tt * 32 + l31) * 128 + kb * 16 + hi * 8);
                    acc[tt] = __builtin_amdgcn_mfma_f32_32x32x16_bf16(af, bfr, acc[tt], 0, 0, 0);
                }
            }
            asm volatile("" ::: "memory");
        }
#pragma unroll
        for (int tt = 0; tt < 4; ++tt)
#pragma unroll
            for (int r = 0; r < 16; ++r) {
                const int t = tt * 32 + crow(r, hi); const size_t row = r0 + t;
                const float z = acc[tt][r] + p.sg_b[(layer * 4 + g) * 128 + t];
                const float u = bf2f(SGU[row * 256 + ch]), gs = bf2f(GSG[row * 256 + ch]);
                Y[row * 1024 + 768 + ch] = (bf16_t)f2bf(u * z * gs);
                if ((r & 3) == 3) asm volatile("" ::: "memory");
            }
    }
    __syncthreads();
}

__device__ __forceinline__ void attn_naive(const Params& p) {
    unsigned char* ws = p.ws;
    int tid = threadIdx.x; asm volatile("" : "+v"(tid)); const int lane = tid & 63, wave = tid >> 6;
    const bf16_t* Q = (const bf16_t*)(ws + WS_Q); const bf16_t* K = (const bf16_t*)(ws + WS_K); const bf16_t* V = (const bf16_t*)(ws + WS_V);
    const bf16_t* GATT = (const bf16_t*)(ws + WS_GATT);
    const float* FC = (const float*)(ws + WS_FC);
    bf16_t* Y = (bf16_t*)(ws + WS_Y);
    for (int bi = blockIdx.x; bi < 512; bi += gridDim.x) {
        const int bh = bi >> 4, j = bi & 15, b = bh >> 3, h = bh & 7;
        const int tb = wave * 16 + ((wave & 1) ? 15 - j : j);
        const int t = tb * 32 + (lane >> 1), dh = (lane & 1) * 32;
        const size_t row = (size_t)b * SEQ + t;
        float q[32], o[32];
#pragma unroll
        for (int i = 0; i < 4; ++i) {
            const uint4 w = *(const uint4*)(Q + row * 512 + h * 64 + dh + i * 8);
            q[i * 8 + 0] = bflo(w.x); q[i * 8 + 1] = bfhi(w.x); q[i * 8 + 2] = bflo(w.y); q[i * 8 + 3] = bfhi(w.y);
            q[i * 8 + 4] = bflo(w.z); q[i * 8 + 5] = bfhi(w.z); q[i * 8 + 6] = bflo(w.w); q[i * 8 + 7] = bfhi(w.w);
        }
#pragma unroll
        for (int d = 0; d < 32; ++d) o[d] = 0.f;
        const float* Fc = FC + (size_t)bh * SEQ;
        const float Fq = Fc[t];
        float m = -INFINITY, l = 0.f;
        const int tmax = tb * 32 + 31;
        for (int s = 0; s <= tmax; ++s) {
            const uint4* kp = (const uint4*)(K + ((size_t)b * SEQ + s) * 512 + h * 64 + dh);
            float dot = 0.f;
#pragma unroll
            for (int i = 0; i < 4; ++i) {
                const uint4 w = kp[i];
                dot += q[i * 8 + 0] * bflo(w.x) + q[i * 8 + 1] * bfhi(w.x) + q[i * 8 + 2] * bflo(w.y) + q[i * 8 + 3] * bfhi(w.y)
                     + q[i * 8 + 4] * bflo(w.z) + q[i * 8 + 5] * bfhi(w.z) + q[i * 8 + 6] * bflo(w.w) + q[i * 8 + 7] * bfhi(w.w);
            }
            dot += __shfl_xor(dot, 1);
            float logit = dot + (Fq - Fc[s]);
            if (s > t) logit = -INFINITY;
            const float mn = fmaxf(m, logit);
            const float alpha = exp2f(m - mn), pr = exp2f(logit - mn);
            l = l * alpha + pr; m = mn;
            const uint4* vp = (const uint4*)(V + ((size_t)b * SEQ + s) * 512 + h * 64 + dh);
#pragma unroll
            for (int i = 0; i < 4; ++i) {
                const uint4 w = vp[i];
                o[i * 8 + 0] = o[i * 8 + 0] * alpha + pr * bflo(w.x); o[i * 8 + 1] = o[i * 8 + 1] * alpha + pr * bfhi(w.x);
                o[i * 8 + 2] = o[i * 8 + 2] * alpha + pr * bflo(w.y); o[i * 8 + 3] = o[i * 8 + 3] * alpha + pr * bfhi(w.y);
                o[i * 8 + 4] = o[i * 8 + 4] * alpha + pr * bflo(w.z); o[i * 8 + 5] = o[i * 8 + 5] * alpha + pr * bfhi(w.z);
                o[i * 8 + 6] = o[i * 8 + 6] * alpha + pr * bflo(w.w); o[i * 8 + 7] = o[i * 8 + 7] * alpha + pr * bfhi(w.w);
            }
        }
        const float rl = 1.f / l;
#pragma unroll
        for (int i = 0; i < 4; ++i) {
            const uint4 gw = *(const uint4*)(GATT + row * 512 + h * 64 + dh + i * 8);
            uint4 ov;
            ov.x = pk2(o[i * 8 + 0] * rl * bflo(gw.x), o[i * 8 + 1] * rl * bfhi(gw.x));
            ov.y = pk2(o[i * 8 + 2] * rl * bflo(gw.y), o[i * 8 + 3] * rl * bfhi(gw.y));
            ov.z = pk2(o[i * 8 + 4] * rl * bflo(gw.z), o[i * 8 + 5] * rl * bfhi(gw.z));
            ov.w = pk2(o[i * 8 + 6] * rl * bflo(gw.w), o[i * 8 + 7] * rl * bfhi(gw.w));
            *(uint4*)(Y + row * 1024 + h * 64 + dh + i * 8) = ov;
        }
    }
}

__global__ void __launch_bounds__(NTHREADS) fwd_megakernel(Params p) {
    extern __shared__ __attribute__((aligned(16))) unsigned char lds[];
    cg::grid_group grid = cg::this_grid();
    unsigned char* ws = p.ws;
    const int G = gridDim.x, blk = blockIdx.x;
    ProjOut PO{(bf16_t*)(ws + WS_Q), (bf16_t*)(ws + WS_K), (bf16_t*)(ws + WS_V), (bf16_t*)(ws + WS_GATT), (bf16_t*)(ws + WS_XLRU), (bf16_t*)(ws + WS_GLRU),
               (bf16_t*)(ws + WS_SGU), (bf16_t*)(ws + WS_SGV), (bf16_t*)(ws + WS_GSG)};

    p0_prologue(p, (float*)lds);
    grid.sync();
    row_pass<true, true>(p, 0, 0, p.x, nullptr, (float*)lds);
    grid.sync();
    for (int layer = 0; layer < NLAYER; ++layer) {
        { pg8::Gemm g{(const bf16_t*)(ws + WS_H), (const bf16_t*)(ws + WS_WINT + layer * WS_WINT_STRIDE), MROWS, NPROJ, DM}; pg8::StaticOrder S; S.init(MROWS, NPROJ, G, blk);
          pg8::EpiProj E{PO};
          pg8::gemm_phase<pg8::EpiProj, pg8::StaticOrder, true, true>((PG8_LAS unsigned char*)lds, g, S, E); }
        grid.sync();
        for (int it = blk; it < 32 + 512 + 128; it += G) {
            if (it < 32) fcum_item(it, (const float*)(ws + WS_LS), (float*)(ws + WS_FC), (float*)lds);
            else if (it < 32 + 512) lru_item<0>(it - 32, layer, p, lds);
            else sg_item(it - 32 - 512, layer, p, lds);
        }
        grid.sync();
        { const int vcu = (G % 8 == 0) ? (blk % 8) * (G / 8) + blk / 8 : blk;
          static_assert(attn_body::ATTN_LDS_BYTES <= 131072, "attention LDS");
          for (int v = vcu; v < 256; v += G) { const int bh = v >> 3, s = v & 7;
            for (int i = 0; i < 2; ++i) attn_body::attn_unit<8>(bh >> 3, bh & 7, i == 0 ? 15 - s : s, (const attn_body::bf16*)(ws + WS_Q), (const attn_body::bf16*)(ws + WS_K), (const attn_body::bf16*)(ws + WS_V),
                (attn_body::bf16*)(ws + WS_Y), (const attn_body::bf16*)(ws + WS_GATT), (const float*)(ws + WS_FC) + (size_t)bh * SEQ, (char*)lds); }
          __syncthreads(); }
        for (int it = blk; it < 512; it += G) lru_item<1>(it, layer, p, lds);
        grid.sync();
        { pg8::Gemm g{(const bf16_t*)(ws + WS_Y), (const bf16_t*)(ws + WS_WOUTT + (size_t)layer * 2 * MiB), MROWS, DM, DM}; pg8::StaticOrder S; S.init(MROWS, DM, G, blk);
          pg8::EpiBf16<0> E{(bf16_t*)(ws + WS_YOUT), DM, nullptr, 0, 0, 1.f};
          pg8::gemm_phase<pg8::EpiBf16<0>, pg8::StaticOrder, true, true>((PG8_LAS unsigned char*)lds, g, S, E); }
        grid.sync();
        if (layer == 0) { row_pass<false, true>(p, 0, 1, p.x, p.out, (float*)lds); grid.sync(); }
        else row_pass<false, false>(p, 1, 1, p.out, p.out, (float*)lds);
    }
}

extern "C" void kernel_launch(void* const* d_in, const int* in_sizes, int n_in, void* d_out, int out_size, void* d_ws, size_t ws_size, hipStream_t stream) {
    static int grid = 0;
    if (grid == 0) {
        if (n_in != 20 || out_size != MROWS * DM || ws_size < WS_END) { fprintf(stderr, "kernel_launch: unexpected shapes (n_in %d out %d ws %zu)\n", n_in, out_size, ws_size); grid = -1; return; }
        int dev = 0, cus = 0, per_cu = 0;
        if (hipGetDevice(&dev) != hipSuccess || hipDeviceGetAttribute(&cus, hipDeviceAttributeMultiprocessorCount, dev) != hipSuccess) { grid = -1; return; }
        if (hipFuncSetAttribute((const void*)fwd_megakernel, hipFuncAttributeMaxDynamicSharedMemorySize, LDS_BYTES) != hipSuccess) { fprintf(stderr, "kernel_launch: hipFuncSetAttribute failed\n"); grid = -1; return; }
        if (hipOccupancyMaxActiveBlocksPerMultiprocessor(&per_cu, (const void*)fwd_megakernel, NTHREADS, LDS_BYTES) != hipSuccess || per_cu < 1) { fprintf(stderr, "kernel_launch: occupancy query says %d\n", per_cu); per_cu = 1; }
        (void)hipGetLastError();
        grid = cus;
    }
    if (grid < 0) return;
    Params p{};
    p.x = (const float*)d_in[0]; p.c = (const float*)d_in[1]; p.ada_w = (const float*)d_in[2]; p.ada_b = (const float*)d_in[3]; p.pre_g = (const float*)d_in[4];
    p.post_g = (const float*)d_in[5]; p.w_in = (const float*)d_in[6]; p.b_f = (const float*)d_in[7]; p.conv_w = (const float*)d_in[8]; p.conv_b = (const float*)d_in[9];
    p.lru_wa = (const float*)d_in[10]; p.lru_ba = (const float*)d_in[11]; p.lru_wx = (const float*)d_in[12]; p.lru_bx = (const float*)d_in[13]; p.lru_lambda = (const float*)d_in[14];
    p.sg_ln_g = (const float*)d_in[15]; p.sg_ln_b = (const float*)d_in[16]; p.sg_w = (const float*)d_in[17]; p.sg_b = (const float*)d_in[18]; p.w_out = (const float*)d_in[19];
    p.out = (float*)d_out; p.ws = (unsigned char*)d_ws;
    void* args[] = {&p};
    hipError_t e = hipLaunchCooperativeKernel((const void*)fwd_megakernel, dim3(grid), dim3(NTHREADS), args, LDS_BYTES, stream);
    if (e != hipSuccess) fprintf(stderr, "kernel_launch: cooperative launch failed: %s (grid %d)\n", hipGetErrorString(e), grid);
}
```

```cpp
#include <hip/hip_runtime.h>
#include <hip/hip_cooperative_groups.h>
#include <cstdio>
#include <cstdint>
namespace cg = cooperative_groups;

typedef unsigned short bf16_t;
typedef short bf16x8 __attribute__((ext_vector_type(8)));
typedef float f32x16 __attribute__((ext_vector_type(16)));
typedef float f32x4 __attribute__((ext_vector_type(4)));

constexpr int NB = 4, SEQ = 4096, DM = 1024, MROWS = NB * SEQ, NLAYER = 2;
constexpr int DIN = 3336, NPROJ = 3328;
constexpr int FCOL = 1536;
constexpr int NTHREADS = 512;
constexpr float EPS = 1e-6f;
constexpr float LOG2E = 1.4426950408889634f;
constexpr float QSCALE = 0.125f * LOG2E;

constexpr size_t MiB = 1u << 20;
constexpr size_t WS_WINT = 2 * MiB;
constexpr size_t WS_WINT_STRIDE = 7 * MiB;
constexpr size_t WS_WOUTT = 16 * MiB;
constexpr size_t WS_MOD = 20 * MiB;
constexpr size_t WS_SGW = 21 * MiB;
constexpr size_t WS_WAT = 22 * MiB;
constexpr size_t WS_LS = 23 * MiB;
constexpr size_t WS_FC = 24 * MiB;
constexpr size_t WS_AGG = 25 * MiB;
constexpr size_t WS_FLAGS = 32768;
constexpr size_t WS_H = 32 * MiB;
constexpr size_t WS_Q = 64 * MiB, WS_K = 80 * MiB, WS_V = 96 * MiB, WS_GATT = 112 * MiB;
constexpr size_t WS_XLRU = 128 * MiB, WS_GLRU = 136 * MiB, WS_SGU = 144 * MiB, WS_SGV = 152 * MiB, WS_GSG = 160 * MiB;
constexpr size_t WS_Y = 168 * MiB;
constexpr size_t WS_YOUT = 64 * MiB;
constexpr size_t WS_END = 200 * MiB;

constexpr int LDS_BYTES = 147456;
constexpr int BARST_OFF = 131072 + 320;
constexpr size_t WS_BAR = 16384;

struct Params {
    const float *x, *c, *ada_w, *ada_b, *pre_g, *post_g, *w_in, *b_f, *conv_w, *conv_b, *lru_wa, *lru_ba, *lru_wx, *lru_bx, *lru_lambda,
        *sg_ln_g, *sg_ln_b, *sg_w, *sg_b, *w_out;
    float* out; unsigned char* ws;
};

__device__ __forceinline__ unsigned f2bf(float f) { unsigned u = __float_as_uint(f); return (u + 0x7fffu + ((u >> 16) & 1u)) >> 16; }
__device__ __forceinline__ unsigned pk2(float lo, float hi) { return f2bf(lo) | (f2bf(hi) << 16); }
__device__ __forceinline__ float bf2f(unsigned h) { return __uint_as_float(h << 16); }
__device__ __forceinline__ float bflo(unsigned w) { return __uint_as_float(w << 16); }
__device__ __forceinline__ float bfhi(unsigned w) { return __uint_as_float(w & 0xffff0000u); }
__device__ __forceinline__ float wave_sum(float v) {
#pragma unroll
    for (int o = 1; o < 64; o <<= 1) v += __shfl_xor(v, o);
    return v;
}
__device__ __forceinline__ float sigmoid_f(float v) { return __builtin_amdgcn_rcpf(1.f + __expf(-v)); }
__device__ __forceinline__ float silu_f(float v) { return v * __builtin_amdgcn_rcpf(1.f + __expf(-v)); }
__device__ __forceinline__ float gelu_f(float v) { const float u = 1.5957691216057308f * (v + 0.044715f * v * v * v); return v * __builtin_amdgcn_rcpf(1.f + __expf(-u)); }
__device__ __forceinline__ int crow(int r, int hi) { return (r & 3) + 8 * (r >> 2) + 4 * hi; }

struct ProjOut { bf16_t *Q, *K, *V, *GATT, *XLRU, *GLRU, *SGU, *SGV, *GSG; };
__device__ __forceinline__ void proj_store(const ProjOut& P, int row, int n, float v) {
    if (n < 512) P.Q[(size_t)row * 512 + n] = (bf16_t)f2bf(v * QSCALE);
    else if (n < 1024) P.K[(size_t)row * 512 + n - 512] = (bf16_t)f2bf(v);
    else if (n < 1536) P.V[(size_t)row * 512 + n - 1024] = (bf16_t)f2bf(v);
    else if (n < 2048) P.GATT[(size_t)row * 512 + n - 1536] = (bf16_t)f2bf(silu_f(v));
    else if (n < 2304) P.XLRU[(size_t)row * 256 + n - 2048] = (bf16_t)f2bf(v);
    else if (n < 2560) P.GLRU[(size_t)row * 256 + n - 2304] = (bf16_t)f2bf(silu_f(v));
    else if (n < 2816) P.SGU[(size_t)row * 256 + n - 2560] = (bf16_t)f2bf(gelu_f(v));
    else if (n < 3072) P.SGV[(size_t)row * 256 + n - 2816] = (bf16_t)f2bf(gelu_f(v));
    else P.GSG[(size_t)row * 256 + n - 3072] = (bf16_t)f2bf(silu_f(v));
}

namespace pg8 {
#define PG8_LAS __attribute__((address_space(3)))
typedef unsigned short bf16_t;
typedef short bf16x8 __attribute__((ext_vector_type(8)));
typedef float f32x4 __attribute__((ext_vector_type(4)));
typedef unsigned u32x4 __attribute__((ext_vector_type(4)));
constexpr int BM = 256, BK = 64, HALF = 128, HTB = HALF * BK * 2  , STAGE_BYTES = 8 * HTB, NXCD = 8, WGM = 8;

__host__ __device__ __forceinline__ int lds_byte(int r, int c) { const int st = (r >> 4) * 2 + (c >> 5), rr = r & 15, cc = c & 31, ob = rr * 64 + cc * 2; return st * 1024 + (ob ^ (((ob >> 9) & 1) << 5)); }
__host__ __device__ __forceinline__ void stage_rc(int b, int& R, int& C) { const int st = b / 1024, sb = b % 1024, swz = sb ^ (((sb >> 9) & 1) << 5); R = (st >> 1) * 16 + swz / 64; C = (st & 1) * 32 + (swz % 64) / 2; }
__host__ __device__ __forceinline__ int perm32(int rho) { const int n = rho >> 4, i = rho & 15; return 8 * (i >> 2) + 4 * n + (i & 3); }

struct Unit { int pm, pn; };
struct Gemm { const bf16_t* A; const bf16_t* Bt; int M, N, K; };

struct StaticOrder {
    int nM, nN, nwg, G, c;
    __host__ __device__ void init(int M, int N, int G_, int c_) { nM = M / BM; nN = N / BM; nwg = nM * nN; G = G_; c = c_; }
    __host__ __device__ bool next(int i, Unit& u) const {
        const long L = (long)i * G + c; if (L >= nwg) return false;
        int wgid = (int)L; { const int q = nwg / NXCD, r = nwg % NXCD, xcd = wgid % NXCD, off = wgid / NXCD; wgid = (xcd < r ? xcd * (q + 1) : r * (q + 1) + (xcd - r) * q) + off; }
        const int nig = WGM * nN, gid = wgid / nig, fm = gid * WGM, gsz = (nM - fm) < WGM ? (nM - fm) : WGM;
        u.pm = fm + ((wgid % nig) % gsz); u.pn = (wgid % nig) / gsz; return true;
    }
    __device__ __forceinline__ void a_ready(const Unit&) const {}
    __device__ __forceinline__ void done(const Unit&) const {}
};

__device__ __forceinline__ unsigned cvt_pk_bf16(float lo, float hi) { unsigned r; asm volatile("v_cvt_pk_bf16_f32 %0, %1, %2" : "=v"(r) : "v"(lo), "v"(hi)); return r; }
typedef float f32x2 __attribute__((ext_vector_type(2)));
__device__ __forceinline__ f32x2 gelu_pk(f32x2 v) {
    const f32x2 av = __builtin_elementwise_abs(v), d = av * 0.2316418882f + 1.0f;
    f32x2 t; t.x = __builtin_amdgcn_rcpf(d.x); t.y = __builtin_amdgcn_rcpf(d.y);
    f32x2 q = t * 0.5307027145f + (-0.7265760135f); q = q * t + 0.7107068705f; q = q * t + (-0.142248368f); q = q * t + 0.127414796f; q = q * t;
    const f32x2 s = (v * v) * (-0.72134752044f);
    f32x2 e; e.x = __builtin_amdgcn_exp2f(s.x); e.y = __builtin_amdgcn_exp2f(s.y);
    const f32x2 m = v * (q * e), r = v - m;
    f32x2 o; o.x = v.x < 0.f ? m.x : r.x; o.y = v.y < 0.f ? m.y : r.y; return o;
}

template <int ACT  > struct EpiBf16 {
    static constexpr bool PERM = true, AFTER_DRAIN = false; static_assert(ACT == 0 || ACT == 1, "EpiBf16: ACT is 0 (none) or 1 (gelu_pk)");
    bf16_t* O; int ldc; const float* bias; int split_cols; size_t split_stride; float scale0;
    __device__ __forceinline__ void operator()(const f32x4 (&acc)[2][2][4][2], const Unit& u, int wr, int wc, int fr, int fq) const {
        const int row0 = u.pm * BM + wr * 64 + fr; int colt = u.pn * BM; bf16_t* base = O;
        float sc = 1.f; if (split_cols) { const int t = colt / split_cols; base += (size_t)t * split_stride; colt -= t * split_cols; if (t == 0) sc = scale0; }
        const int col0 = colt + wc * 32 + 8 * fq, bcol0 = u.pn * BM + wc * 32 + 8 * fq;
        f32x4 bv[2][2];
#pragma unroll
        for (int bj = 0; bj < 2; ++bj)
#pragma unroll
            for (int n = 0; n < 2; ++n) bv[bj][n] = bias ? *(const f32x4*)(bias + bcol0 + bj * HALF + 4 * n) : (f32x4){0.f, 0.f, 0.f, 0.f};
#pragma unroll
        for (int ai = 0; ai < 2; ++ai)
#pragma unroll
            for (int m = 0; m < 4; ++m) { bf16_t* rowp = base + (size_t)(row0 + ai * HALF + m * 16) * ldc + col0;
#pragma unroll
                for (int bj = 0; bj < 2; ++bj) { f32x4 v0 = acc[ai][bj][m][0] + bv[bj][0], v1 = acc[ai][bj][m][1] + bv[bj][1];
                    if (ACT == 1) { f32x2 a = gelu_pk((f32x2){v0[0], v0[1]}), b = gelu_pk((f32x2){v0[2], v0[3]}), c = gelu_pk((f32x2){v1[0], v1[1]}), d = gelu_pk((f32x2){v1[2], v1[3]});
                        v0 = (f32x4){a.x, a.y, b.x, b.y}; v1 = (f32x4){c.x, c.y, d.x, d.y}; }
                    v0 = v0 * sc; v1 = v1 * sc; u32x4 w; w.x = cvt_pk_bf16(v0[0], v0[1]); w.y = cvt_pk_bf16(v0[2], v0[3]); w.z = cvt_pk_bf16(v1[0], v1[1]); w.w = cvt_pk_bf16(v1[2], v1[3]);
                    *(u32x4*)(rowp + bj * HALF) = w; } }
    }
};

struct EpiProj {
    static constexpr bool PERM = true, AFTER_DRAIN = false;
    ::ProjOut P;
    __device__ __forceinline__ void operator()(const f32x4 (&acc)[2][2][4][2], const Unit& u, int wr, int wc, int fr, int fq) const {
        const int pn = u.pn;
        bf16_t* base; int ldc = 512, colt = 0, act = 0; float sc = 1.f;
        if (pn < 2) { base = P.Q; colt = pn * 256; sc = ::QSCALE; }
        else if (pn < 4) { base = P.K; colt = (pn - 2) * 256; }
        else if (pn < 6) { base = P.V; colt = (pn - 4) * 256; }
        else if (pn < 8) { base = P.GATT; colt = (pn - 6) * 256; act = 1; }
        else { ldc = 256; base = (pn == 8) ? P.XLRU : (pn == 9) ? P.GLRU : (pn == 10) ? P.SGU : (pn == 11) ? P.SGV : P.GSG; act = (pn == 8) ? 0 : ((pn == 10 || pn == 11) ? 2 : 1); }
        const int row0 = u.pm * BM + wr * 64 + fr, col0 = colt + wc * 32 + 8 * fq;
#pragma unroll
        for (int ai = 0; ai < 2; ++ai)
#pragma unroll
            for (int m = 0; m < 4; ++m) { bf16_t* rowp = base + (size_t)(row0 + ai * HALF + m * 16) * ldc + col0;
#pragma unroll
                for (int bj = 0; bj < 2; ++bj) { f32x4 v0 = acc[ai][bj][m][0], v1 = acc[ai][bj][m][1];
                    if (act == 1) {
#pragma unroll
                        for (int e = 0; e < 4; ++e) { v0[e] = ::silu_f(v0[e]); v1[e] = ::silu_f(v1[e]); }
                    } else if (act == 2) {
#pragma unroll
                        for (int e = 0; e < 4; ++e) { v0[e] = ::gelu_f(v0[e]); v1[e] = ::gelu_f(v1[e]); }
                    }
                    v0 = v0 * sc; v1 = v1 * sc; u32x4 w; w.x = cvt_pk_bf16(v0[0], v0[1]); w.y = cvt_pk_bf16(v0[2], v0[3]); w.z = cvt_pk_bf16(v1[0], v1[1]); w.w = cvt_pk_bf16(v1[2], v1[3]);
                    *(u32x4*)(rowp + bj * HALF) = w; } }
    }
};

template <class Epi, class Sched, bool ALIGN_EPI = false, bool SP2 = false>
__device__ __forceinline__ void gemm_phase(PG8_LAS unsigned char* lds, const Gemm g, const Sched& S, const Epi& E) {
    int tid = threadIdx.x; asm volatile("" : "+v"(tid)); const int wid = __builtin_amdgcn_readfirstlane(tid >> 6), lane = tid & 63, wr = wid >> 2, wc = wid & 3, fr = lane & 15, fq = lane >> 4;
    const int K = g.K, nt = K / BK;
    unsigned voffA[2], voffB[2];
#pragma unroll
    for (int i = 0; i < 2; ++i) { int R, C; stage_rc(tid * 16 + i * 8192, R, C); const int Rb = Epi::PERM ? ((R & ~31) + perm32(R & 31)) : R;
        voffA[i] = (unsigned)(R * K + C) * 2u; voffB[i] = (unsigned)(Rb * K + C) * 2u; }
    const size_t kstep = (size_t)(BK * 2);
    const size_t hstep = (size_t)HALF * K * 2;
    const size_t tstep = 2 * hstep;
    const unsigned ldsw = (unsigned)wid * 1024u;
    const int aoff = lds_byte(wr * 64 + fr, fq * 8), boff = lds_byte(wc * 32 + fr, fq * 8);
#define PG8_SA(b, h) (((b) * 2 + (h)) * HTB)
#define PG8_SB(b, h) ((4 + (b) * 2 + (h)) * HTB)
#define PG8_STAGE(bufoff, gbase, voff) do { _Pragma("unroll") for (int _i = 0; _i < 2; ++_i) \
        __builtin_amdgcn_global_load_lds((const unsigned*)((const char*)(gbase) + (voff)[_i]), (PG8_LAS unsigned*)(lds + (bufoff) + ldsw + _i * 8192), 16, 0, 0); } while (0)
#define PG8_LDA(dst, b, h) do { _Pragma("unroll") for (int m = 0; m < 4; ++m) _Pragma("unroll") for (int k = 0; k < 2; ++k) dst[m][k] = *(const PG8_LAS bf16x8*)(lds + PG8_SA(b, h) + aoff + m * 2048 + k * 1024); } while (0)
#define PG8_LDB(dst, b, h) do { _Pragma("unroll") for (int n = 0; n < 2; ++n) _Pragma("unroll") for (int k = 0; k < 2; ++k) dst[n][k] = *(const PG8_LAS bf16x8*)(lds + PG8_SB(b, h) + boff + n * 2048 + k * 1024); } while (0)
#define PG8_MMA(ai, bj, At, Bt) do { __builtin_amdgcn_s_setprio(1); _Pragma("unroll") for (int m = 0; m < 4; ++m) _Pragma("unroll") for (int n = 0; n < 2; ++n) _Pragma("unroll") for (int k = 0; k < 2; ++k) \
        acc[ai][bj][m][n] = __builtin_amdgcn_mfma_f32_16x16x32_bf16(Bt[n][k], At[m][k], acc[ai][bj][m][n], 0, 0, 0); __builtin_amdgcn_s_setprio(0); } while (0)
#define PG8_WAIT_V(n) asm volatile("s_waitcnt vmcnt(" #n ")" ::: "memory")
#define PG8_WAIT_L(n) asm volatile("s_waitcnt lgkmcnt(" #n ")" ::: "memory")
#define PG8_BAR __builtin_amdgcn_s_barrier()
#define PG8_SCHED __builtin_amdgcn_sched_barrier(0)
    Unit cur, nxt; int ui = 0;
    if (!S.next(0, cur)) return;
    f32x4 acc[2][2][4][2];
#pragma unroll
    for (int a = 0; a < 2; ++a)
#pragma unroll
        for (int b = 0; b < 2; ++b)
#pragma unroll
            for (int m = 0; m < 4; ++m)
#pragma unroll
                for (int n = 0; n < 2; ++n) acc[a][b][m][n] = (f32x4){0.f, 0.f, 0.f, 0.f};
    bf16x8 At[4][2], B0[2][2], B1[2][2];
    const char* cA = (const char*)g.A + (size_t)cur.pm * tstep; const char* cB = (const char*)g.Bt + (size_t)cur.pn * tstep;
    S.a_ready(cur);
    if constexpr (SP2) {
        PG8_STAGE(PG8_SB(0, 0), cB, voffB); PG8_STAGE(PG8_SB(0, 1), cB + hstep, voffB); PG8_STAGE(PG8_SA(0, 0), cA, voffA); PG8_STAGE(PG8_SA(0, 1), cA + hstep, voffA);
        if (wr == 1) PG8_BAR;
        PG8_WAIT_V(2); PG8_BAR;
        PG8_STAGE(PG8_SB(1, 0), cB + kstep, voffB); PG8_STAGE(PG8_SA(1, 0), cA + kstep, voffA); PG8_STAGE(PG8_SB(1, 1), cB + hstep + kstep, voffB);
        PG8_WAIT_V(6); PG8_BAR;
    } else {
        PG8_STAGE(PG8_SB(0, 0), cB, voffB); PG8_STAGE(PG8_SA(0, 0), cA, voffA); PG8_STAGE(PG8_SB(0, 1), cB + hstep, voffB); PG8_STAGE(PG8_SA(0, 1), cA + hstep, voffA);
        if (wr == 1) PG8_BAR;
        PG8_WAIT_V(4); PG8_BAR;
        PG8_STAGE(PG8_SB(1, 0), cB + kstep, voffB); PG8_STAGE(PG8_SA(1, 0), cA + kstep, voffA); PG8_STAGE(PG8_SB(1, 1), cB + hstep + kstep, voffB);
        PG8_WAIT_V(6); PG8_BAR;
    }
    for (;;) {
        const bool has_next = S.next(ui + 1, nxt);
        const char* nA = has_next ? (const char*)g.A + (size_t)nxt.pm * tstep : cA; const char* nB = has_next ? (const char*)g.Bt + (size_t)nxt.pn * tstep : cB;
        for (int t = 0; t < nt; t += 2) {
            const bool last = (t == nt - 2);
            const char* a1 = cA + (size_t)(t + 1) * kstep;
            const char* a2 = last ? nA : cA + (size_t)(t + 2) * kstep; const char* b2 = last ? nB : cB + (size_t)(t + 2) * kstep;
            const char* a3 = a2 + kstep; const char* b3 = b2 + kstep;
            if (last && has_next) S.a_ready(nxt);
            if constexpr (SP2) {
            PG8_LDB(B0, 0, 0); PG8_LDB(B1, 0, 1); PG8_SCHED; PG8_LDA(At, 0, 0); PG8_STAGE(PG8_SA(1, 1), a1 + hstep, voffA);
            PG8_WAIT_V(8); PG8_WAIT_L(0); PG8_BAR; PG8_MMA(0, 0, At, B0); PG8_MMA(0, 1, At, B1); PG8_BAR; PG8_SCHED;
            PG8_LDA(At, 0, 1); PG8_STAGE(PG8_SB(0, 0), b2, voffB); PG8_STAGE(PG8_SB(0, 1), b2 + hstep, voffB); PG8_STAGE(PG8_SA(0, 0), a2, voffA);
            PG8_WAIT_V(8); PG8_WAIT_L(0); PG8_BAR; PG8_MMA(1, 0, At, B0); PG8_MMA(1, 1, At, B1); PG8_BAR; PG8_SCHED;
            PG8_LDB(B0, 1, 0); PG8_LDB(B1, 1, 1); PG8_SCHED; PG8_LDA(At, 1, 0); PG8_STAGE(PG8_SA(0, 1), a2 + hstep, voffA);
            PG8_WAIT_V(8); PG8_WAIT_L(0); PG8_BAR; PG8_MMA(0, 0, At, B0); PG8_MMA(0, 1, At, B1); PG8_BAR; PG8_SCHED;
            PG8_LDA(At, 1, 1); PG8_STAGE(PG8_SB(1, 0), b3, voffB); PG8_STAGE(PG8_SB(1, 1), b3 + hstep, voffB); PG8_STAGE(PG8_SA(1, 0), a3, voffA);
            PG8_WAIT_V(8); PG8_WAIT_L(0); PG8_BAR; PG8_MMA(1, 0, At, B0); PG8_MMA(1, 1, At, B1); PG8_BAR; PG8_SCHED;
            } else {
            PG8_LDB(B0, 0, 0); PG8_SCHED; PG8_LDA(At, 0, 0); PG8_STAGE(PG8_SA(1, 1), a1 + hstep, voffA);
            PG8_WAIT_L(8); PG8_BAR; PG8_WAIT_L(0); PG8_MMA(0, 0, At, B0); PG8_BAR; PG8_SCHED;
            PG8_LDB(B1, 0, 1); PG8_STAGE(PG8_SB(0, 0), b2, voffB);
            PG8_BAR; PG8_WAIT_L(0); PG8_MMA(0, 1, At, B1); PG8_BAR;
            PG8_LDA(At, 0, 1); PG8_STAGE(PG8_SA(0, 0), a2, voffA);
            PG8_BAR; PG8_WAIT_L(0); PG8_MMA(1, 0, At, B0); PG8_BAR; PG8_SCHED;
            PG8_STAGE(PG8_SB(0, 1), b2 + hstep, voffB);
            PG8_WAIT_V(6); PG8_BAR; PG8_MMA(1, 1, At, B1); PG8_BAR;
            PG8_LDB(B0, 1, 0); PG8_SCHED; PG8_LDA(At, 1, 0); PG8_STAGE(PG8_SA(0, 1), a2 + hstep, voffA);
            PG8_WAIT_L(8); PG8_BAR; PG8_WAIT_L(0); PG8_MMA(0, 0, At, B0); PG8_BAR; PG8_SCHED;
            PG8_LDB(B1, 1, 1); PG8_STAGE(PG8_SB(1, 0), b3, voffB);
            PG8_BAR; PG8_WAIT_L(0); PG8_MMA(0, 1, At, B1); PG8_BAR;
            PG8_LDA(At, 1, 1); PG8_STAGE(PG8_SA(1, 0), a3, voffA);
            PG8_BAR; PG8_WAIT_L(0); PG8_MMA(1, 0, At, B0); PG8_BAR; PG8_SCHED;
            PG8_STAGE(PG8_SB(1, 1), b3 + hstep, voffB);
            PG8_WAIT_V(6); PG8_BAR; PG8_MMA(1, 1, At, B1); PG8_BAR;
            }
        }
        if constexpr (ALIGN_EPI) { if (wr == 0) PG8_BAR; }
        if constexpr (!Epi::AFTER_DRAIN) { E(acc, cur, wr, wc, fr, fq); S.done(cur); }
        if (!has_next) break;
#pragma unroll
        for (int a = 0; a < 2; ++a)
#pragma unroll
            for (int b = 0; b < 2; ++b)
#pragma unroll
                for (int m = 0; m < 4; ++m)
#pragma unroll
                    for (int n = 0; n < 2; ++n) acc[a][b][m][n] = (f32x4){0.f, 0.f, 0.f, 0.f};
        cur = nxt; cA = nA; cB = nB; ++ui;
        if constexpr (ALIGN_EPI) { if (wr == 1) PG8_BAR; }
    }
    PG8_WAIT_V(0);
    if constexpr (!ALIGN_EPI) { if (wr == 0) PG8_BAR; }
    PG8_BAR;
    if constexpr (Epi::AFTER_DRAIN) { E.fused(acc, cur, wr, wc, fr, fq, lds, wid, lane); S.done(cur); }
#undef PG8_SA
#undef PG8_SB
#undef PG8_STAGE
#undef PG8_LDA
#undef PG8_LDB
#undef PG8_MMA
#undef PG8_WAIT_V
#undef PG8_WAIT_L
#undef PG8_BAR
#undef PG8_SCHED
}
}

#include <hip/hip_bf16.h>
#include <cmath>
namespace attn_body {
using bf16=__hip_bfloat16;
using bf16x8=__attribute__((ext_vector_type(8)))short;
using s16x4=__attribute__((ext_vector_type(4)))short;
using f32x16=__attribute__((ext_vector_type(16)))float;
using u32x4=__attribute__((ext_vector_type(4)))unsigned;
using f32x4=__attribute__((ext_vector_type(4)))float;
constexpr int BATCH=4,NHEAD=8,SEQ=4096,D=64,DM=NHEAD*D,ODM=1024;
constexpr int NW=8,QBLK=32,QB=QBLK*NW,KVBLK=64,NQB=SEQ/QB;
constexpr int ATTN_PITCH=DM, ATTN_UNIT_ROWS=QB;
__device__ __forceinline__ int crow(int r,int hi){return (r&3)+8*(r>>2)+4*hi;}
#define SBAR() __builtin_amdgcn_sched_barrier(0)
__device__ __forceinline__ void cmask(f32x16&p0,f32x16&p1,int jb,int qrel,int hi){
  const float NEG=-INFINITY; int kb=64*jb+4*hi;
  #pragma unroll
  for(int r=0;r<16;++r){int kv=kb+(r&3)+8*(r>>2); if(kv>qrel)p0[r]=NEG; if(kv+32>qrel)p1[r]=NEG;}
}

constexpr int NSLOT=3, SLOTB=8192;
constexpr int LDS_K=0, LDS_V=NSLOT*SLOTB, LDS_WS=2*NSLOT*SLOTB, LDS_OST=LDS_WS+NW*64*4, LDS_FK=LDS_OST+NW*4096, LDS_BYTES=LDS_FK+SEQ*4+4096;
constexpr float C2=0.125f*1.4426950408889634f;
__device__ __forceinline__ void glds16(const void*gsrc,unsigned lds_dst){unsigned keep;
  asm volatile("s_mov_b32 %0, m0\n\ts_mov_b32 m0, %2\n\ts_nop 0\n\tglobal_load_lds_dwordx4 %1, off\n\ts_mov_b32 m0, %0":"=&s"(keep):"v"(gsrc),"s"(lds_dst):"memory");}
__device__ __forceinline__ float max3f(float a,float b,float c){float r;asm("v_max3_f32 %0, %1, %2, %3":"=v"(r):"v"(a),"v"(b),"v"(c));return r;}
__device__ __forceinline__ float max2f(float a,float b){float r;asm("v_max_f32_e32 %0, %1, %2":"=v"(r):"v"(a),"v"(b));return r;}
__device__ __forceinline__ float fadd_s(float a,float b){float r;asm("v_add_f32_e32 %0, %1, %2":"=v"(r):"v"(a),"v"(b));return r;}
__device__ __forceinline__ float fsub_s(float a,float b){float r;asm("v_sub_f32_e32 %0, %1, %2":"=v"(r):"v"(a),"v"(b));return r;}
typedef float f32x2_t __attribute__((ext_vector_type(2))); typedef __bf16 bf16x2_t __attribute__((ext_vector_type(2)));
__device__ __forceinline__ unsigned cvtpk_s(float lo,float hi){f32x2_t v={lo,hi};bf16x2_t b=__builtin_convertvector(v,bf16x2_t);return __builtin_bit_cast(unsigned,b);}
#define WAIT_BAR(N) asm volatile("s_waitcnt vmcnt(" #N ") lgkmcnt(0)\n\ts_barrier":::"memory")

__device__ __forceinline__ void qkt(f32x16&p0,f32x16&p1,const char*Kslot,const bf16x8*qr,int r32,int hi){
  const char*kb=Kslot+hi*1024+r32*16;
  #pragma unroll
  for(int d0=0;d0<4;++d0){
    const bf16x8 b0=*reinterpret_cast<const bf16x8*>(kb+d0*2048);
    const bf16x8 b1=*reinterpret_cast<const bf16x8*>(kb+d0*2048+512);
    p0=__builtin_amdgcn_mfma_f32_32x32x16_bf16(b0,qr[d0],p0,0,0,0);p1=__builtin_amdgcn_mfma_f32_32x32x16_bf16(b1,qr[d0],p1,0,0,0);}
}
typedef __attribute__((address_space(3))) const char* lds_cptr;
typedef short v4i16_t __attribute__((ext_vector_type(4)));
__device__ __forceinline__ void kload8(bf16x8*kf,lds_cptr kp){
  kf[0]=*(const __attribute__((address_space(3))) bf16x8*)(kp);      kf[1]=*(const __attribute__((address_space(3))) bf16x8*)(kp+512);
  kf[2]=*(const __attribute__((address_space(3))) bf16x8*)(kp+2048); kf[3]=*(const __attribute__((address_space(3))) bf16x8*)(kp+2560);
  kf[4]=*(const __attribute__((address_space(3))) bf16x8*)(kp+4096); kf[5]=*(const __attribute__((address_space(3))) bf16x8*)(kp+4608);
  kf[6]=*(const __attribute__((address_space(3))) bf16x8*)(kp+6144); kf[7]=*(const __attribute__((address_space(3))) bf16x8*)(kp+6656);
}
__device__ __forceinline__ void kload2(bf16x8*kf,lds_cptr kp,int j){ kf[2*j]=*(const __attribute__((address_space(3))) bf16x8*)(kp+j*2048); kf[2*j+1]=*(const __attribute__((address_space(3))) bf16x8*)(kp+j*2048+512); }
__device__ __forceinline__ s16x4 vtr(lds_cptr p){ return __builtin_bit_cast(s16x4,__builtin_amdgcn_ds_read_tr16_b64_v4i16((__attribute__((address_space(3))) v4i16_t*)p)); }
__device__ __forceinline__ float rowmax(const f32x16&p0,const f32x16&p1){
  float a=max3f(p0[0],p0[1],p1[0]),b=max3f(p0[2],p0[3],p1[1]);a=max3f(a,p1[2],p1[3]);
  #pragma unroll
  for(int r=4;r<16;r+=4){a=max3f(a,p0[r],p0[r+1]);b=max3f(b,p0[r+2],p0[r+3]);a=max3f(a,p1[r],p1[r+1]);b=max3f(b,p1[r+2],p1[r+3]);}
  const float m=max2f(a,b);
  auto rr=__builtin_amdgcn_permlane32_swap(__float_as_uint(m),__float_as_uint(m),false,false);
  return max2f(__uint_as_float(rr[0]),__uint_as_float(rr[1]));
}
__device__ __forceinline__ void pv(f32x16*o,int vb,bf16x8 pa0,bf16x8 pa1,bf16x8 pa2,bf16x8 pa3){
  #pragma unroll
  for(int d0=0;d0<2;++d0){s16x4 lo[4],hi[4];
    #pragma unroll
    for(int ks=0;ks<4;++ks){
      asm volatile("ds_read_b64_tr_b16 %0,%1 offset:%c2":"=&v"(lo[ks]):"v"(vb),"i"(d0*4096+ks*1024):"memory");
      asm volatile("ds_read_b64_tr_b16 %0,%1 offset:%c2":"=&v"(hi[ks]):"v"(vb),"i"(d0*4096+ks*1024+512):"memory");}
    asm volatile("s_waitcnt lgkmcnt(0)":::"memory");SBAR();
    #define PK(k) (bf16x8){lo[k][0],lo[k][1],lo[k][2],lo[k][3],hi[k][0],hi[k][1],hi[k][2],hi[k][3]}
    o[d0]=__builtin_amdgcn_mfma_f32_32x32x16_bf16(pa0,PK(0),o[d0],0,0,0);
    o[d0]=__builtin_amdgcn_mfma_f32_32x32x16_bf16(pa1,PK(1),o[d0],0,0,0);
    o[d0]=__builtin_amdgcn_mfma_f32_32x32x16_bf16(pa2,PK(2),o[d0],0,0,0);
    o[d0]=__builtin_amdgcn_mfma_f32_32x32x16_bf16(pa3,PK(3),o[d0],0,0,0);
    #undef PK
  }
}

#ifndef ATTN_STORE16
#define ATTN_STORE16(p,v) (*(u32x4*)(p)=(v))
#endif
template<int THRL,bool STAGE_FK> __device__ __forceinline__ void attn_unit(int b,int h,int qb,const bf16*Q,const bf16*__restrict__ K,const bf16*__restrict__ V,bf16*O,const bf16*__restrict__ Gt,const float*__restrict__ Fc,char*shm){
  int tid=threadIdx.x; asm volatile("":"+v"(tid)); const int lane=tid&63,r32=lane&31,hi=lane>>5; const int wid=__builtin_amdgcn_readfirstlane(tid>>6);
  const long rowbase=(long)b*SEQ; const int q0=qb*QB;
  const bf16*Qw=Q+(rowbase+q0+wid*QBLK)*DM+h*D;
  const bf16*Kh=K+rowbase*DM+h*D,*Vh=V+rowbase*DM+h*D;
  const unsigned lds0=(unsigned)(uintptr_t)shm;
  float*wsf=(float*)(shm+LDS_WS)+wid*64;
  const bf16*ksrc=Kh+(long)lane*DM+wid*8;
  const bf16*vsrc=Vh+(long)(16*(wid&3)+(lane>>2))*DM+(wid>>2)*32+(lane&3)*8;
  const unsigned kdst=lds0+LDS_K+wid*1024, vdst=lds0+LDS_V+wid*1024;
  #define DMA_K(t,slot) glds16(ksrc+(long)(t)*KVBLK*DM,(unsigned)__builtin_amdgcn_readfirstlane(kdst+(slot)))
  #define DMA_V(t,slot) glds16(vsrc+(long)(t)*KVBLK*DM,(unsigned)__builtin_amdgcn_readfirstlane(vdst+(slot)))
  const int vb0=(int)(lds0+LDS_V)+((lane>>4)&1)*32+(lane&3)*8+(4*hi+((lane&15)>>2))*64;
  const char*Kbase=shm+LDS_K; bf16x8 kf[8];
  const lds_cptr shm3=(lds_cptr)shm; const lds_cptr kp0=shm3+LDS_K+hi*1024+r32*16; const lds_cptr vp0=shm3+LDS_V+((lane>>4)&1)*32+(lane&3)*8+(4*hi+((lane&15)>>2))*64;
  const int NT=(q0+QB)/KVBLK;
  float fqm;
  if(STAGE_FK){ f32x4*fkw=(f32x4*)(shm+LDS_FK); const int n4=(q0+QB)>>2; for(int i=tid;i<n4;i+=NW*64)fkw[i]=((const f32x4*)Fc)[i];
    fqm=Fc[q0+wid*QBLK+r32]; asm volatile("s_waitcnt vmcnt(0) lgkmcnt(0)\n\ts_barrier":::"memory"); }
  else fqm=((const float*)(shm+LDS_FK))[q0+wid*QBLK+r32];
  typedef __attribute__((address_space(3))) const f32x4* lds_f4ptr;
  const lds_cptr fk0=(lds_cptr)shm+LDS_FK+hi*16;
  #define CINIT(C0,C1,t) do{ const lds_cptr fp_=fk0+(t)*256; \
    _Pragma("unroll") for(int g_=0;g_<4;++g_){ const f32x4 a_=*(lds_f4ptr)(fp_+g_*32); const f32x4 b_=*(lds_f4ptr)(fp_+128+g_*32); \
      _Pragma("unroll") for(int e_=0;e_<4;++e_){ C0[g_*4+e_]=fqm-a_[e_]; C1[g_*4+e_]=fqm-b_[e_]; } } }while(0)
  DMA_K(0,0);DMA_V(0,0);DMA_K(1,SLOTB);
  bf16x8 qr[4];
  #pragma unroll
  for(int d0=0;d0<4;++d0)qr[d0]=*reinterpret_cast<const bf16x8*>(&Qw[(long)r32*DM+d0*16+hi*8]);
  float l_reg=0.f;f32x16 o[2];o[0]=f32x16{};o[1]=f32x16{};
  const int qrel=wid*QBLK+r32;
  #define CMASK(P0,P1,t) do{int jb_=(t)-(NT-4); if(jb_>=0)cmask(P0,P1,jb_,qrel,hi);}while(0)
  bool resc=false;
  #define START(P0,P1) do{ const float rm=rowmax(P0,P1); resc=false; \
    { const float dl=rm; fqm=fsub_s(fqm,dl); \
      _Pragma("unroll") for(int r=0;r<16;++r){P0[r]=fsub_s(P0[r],dl);P1[r]=fsub_s(P1[r],dl);} } \
    _Pragma("unroll") for(int r=0;r<16;++r)P0[r]=__builtin_amdgcn_exp2f(P0[r]); }while(0)
  #define RESC() do{ if(resc){ asm volatile("s_waitcnt lgkmcnt(0)":::"memory"); \
      _Pragma("unroll") for(int d_=0;d_<2;++d_) _Pragma("unroll") for(int r=0;r<16;++r)o[d_][r]*=wsf[crow(r,hi)]; } }while(0)
  f32x16 pA0,pA1,pB0,pB1;
  int sl_prev=0,sl_cur=0,sl_next=SLOTB;
  #define ROT() do{sl_prev=sl_cur;sl_cur=sl_next;sl_next=(sl_next==(NSLOT-1)*SLOTB)?0:sl_next+SLOTB;}while(0)
  DMA_K(2,2*SLOTB);
  WAIT_BAR(3);
  CINIT(pA0,pA1,0); qkt(pA0,pA1,Kbase,qr,r32,hi);asm volatile("s_nop 15\n\ts_nop 7":"+v"(pA0),"+v"(pA1));CMASK(pA0,pA1,0);
  START(pA0,pA1);
  _Pragma("unroll") for(int r=0;r<16;++r)pA1[r]=__builtin_amdgcn_exp2f(pA1[r]);
  WAIT_BAR(0);
  DMA_K(3,0);DMA_V(1,SLOTB);
  ROT();
  kload8(kf,kp0+sl_cur);
  WAIT_BAR(2);
  s16x4 vlo[8],vhi[8]; u32x4 pw0,pw1,pw2,pw3;
  #define PKW(P,B) cvtpk_s(P[B],P[B+1])
  #define PAF(k) __builtin_bit_cast(bf16x8,pw##k)
  #define VFR(i) (bf16x8){vlo[i][0],vlo[i][1],vlo[i][2],vlo[i][3],vhi[i][0],vhi[i][1],vhi[i][2],vhi[i][3]}
  #define PIN(x) asm volatile("":"+v"(x))
  #define MX3(a,b,c) __builtin_fmaxf(__builtin_fmaxf((a),(b)),(c))
  #define GAPA(MF,A0,A1,A2,A3,W0,W1,PW) do{ MF; sacc+=A0; sacc+=A1; sacc+=A2; sacc+=A3; PIN(sacc); W0; W1; PIN(PW); SBAR(); }while(0)
  #define EX(v) __builtin_amdgcn_exp2f(v)
  #define GAPB(MF,X,B) do{ MF; X[B]=EX(X[B]); X[B+1]=EX(X[B+1]); X[B+2]=EX(X[B+2]); X[B+3]=EX(X[B+3]); PIN(X); SBAR(); }while(0)
  #define VRD(i) do{ vlo[i]=vtr(vp_+(((i)>>2)*4096+((i)&3)*1024)); vhi[i]=vtr(vp_+(((i)>>2)*4096+((i)&3)*1024+512)); }while(0)
  #define KRD(G,j) do{ if(G){ kload2(kf,kp0+sl_next,j); SBAR(); } }while(0)
  #define STEP(C0,C1,P0,P1,t,GK,GV,GL) do{ SBAR(); CINIT(C0,C1,t); SBAR(); \
    const lds_cptr vp_=vp0+sl_prev; \
    VRD(0); SBAR(); float sacc=(P0[0]+P0[1]); \
    GAPA(C0=__builtin_amdgcn_mfma_f32_32x32x16_bf16(kf[0],qr[0],C0,0,0,0), P0[2],P0[3],P0[4],P0[5],     pw0[0]=PKW(P0,0), pw0[1]=PKW(P0,2), pw0); \
    VRD(4); SBAR(); GAPA(C1=__builtin_amdgcn_mfma_f32_32x32x16_bf16(kf[1],qr[0],C1,0,0,0), P0[6],P0[7],P0[8],P0[9],     pw0[2]=PKW(P0,4), pw0[3]=PKW(P0,6), pw0); \
    VRD(1); SBAR(); GAPA(C0=__builtin_amdgcn_mfma_f32_32x32x16_bf16(kf[2],qr[1],C0,0,0,0),   P0[10],P0[11],P0[12],P0[13], pw1[0]=PKW(P0,8), pw1[1]=PKW(P0,10), pw1); \
    VRD(5); SBAR(); GAPA(C1=__builtin_amdgcn_mfma_f32_32x32x16_bf16(kf[3],qr[1],C1,0,0,0),   P0[14],P0[15],P1[0],P1[1],   pw1[2]=PKW(P0,12),pw1[3]=PKW(P0,14), pw1); \
    VRD(2); SBAR(); GAPA(C0=__builtin_amdgcn_mfma_f32_32x32x16_bf16(kf[4],qr[2],C0,0,0,0),   P1[2],P1[3],P1[4],P1[5],     pw2[0]=PKW(P1,0), pw2[1]=PKW(P1,2), pw2); \
    VRD(6); SBAR(); GAPA(C1=__builtin_amdgcn_mfma_f32_32x32x16_bf16(kf[5],qr[2],C1,0,0,0),   P1[6],P1[7],P1[8],P1[9],     pw2[2]=PKW(P1,4), pw2[3]=PKW(P1,6), pw2); \
    VRD(3); SBAR(); GAPA(C0=__builtin_amdgcn_mfma_f32_32x32x16_bf16(kf[6],qr[3],C0,0,0,0),   P1[10],P1[11],P1[12],P1[13], pw3[0]=PKW(P1,8), pw3[1]=PKW(P1,10), pw3); \
    VRD(7); SBAR(); GAPA(C1=__builtin_amdgcn_mfma_f32_32x32x16_bf16(kf[7],qr[3],C1,0,0,0),   P1[14],P1[15],0.f,0.f,       pw3[2]=PKW(P1,12),pw3[3]=PKW(P1,14), pw3); \
    l_reg+=sacc; \
    if(GK){DMA_K((t)+3,sl_cur);} if(GV){DMA_V((t)+1,sl_next);} \
    CMASK(C0,C1,t); \
    { float a=MX3(C0[0],C0[1],C1[0]),b=MX3(C0[2],C0[3],C1[1]); a=MX3(a,C1[2],C1[3]); \
      _Pragma("unroll") for(int r=4;r<16;r+=4){a=MX3(a,C0[r],C0[r+1]);b=MX3(b,C0[r+2],C0[r+3]);a=MX3(a,C1[r],C1[r+1]);b=MX3(b,C1[r+2],C1[r+3]);} \
      float rm=__builtin_fmaxf(a,b); { auto rr=__builtin_amdgcn_permlane32_swap(__float_as_uint(rm),__float_as_uint(rm),false,false); rm=__builtin_fmaxf(__uint_as_float(rr[0]),__uint_as_float(rr[1])); } \
      resc=false; \
      if(__builtin_expect(__any(rm>(float)THRL),0)){ const float dl=__builtin_fmaxf(rm,0.f); fqm-=dl; \
        _Pragma("unroll") for(int r=0;r<16;++r){C0[r]-=dl;C1[r]-=dl;} \
        const float f=__builtin_amdgcn_exp2f(-dl); l_reg*=f; if(hi==0)wsf[r32]=f; resc=true; } } \
    SBAR(); \
    GAPB(o[0]=__builtin_amdgcn_mfma_f32_32x32x16_bf16(PAF(0),VFR(0),o[0],0,0,0), C0,0); \
    GAPB(o[1]=__builtin_amdgcn_mfma_f32_32x32x16_bf16(PAF(0),VFR(4),o[1],0,0,0), C0,4); \
    KRD(GL,0); GAPB(o[0]=__builtin_amdgcn_mfma_f32_32x32x16_bf16(PAF(1),VFR(1),o[0],0,0,0), C0,8); \
    KRD(GL,1); GAPB(o[1]=__builtin_amdgcn_mfma_f32_32x32x16_bf16(PAF(1),VFR(5),o[1],0,0,0), C0,12); \
    KRD(GL,2); GAPB(o[0]=__builtin_amdgcn_mfma_f32_32x32x16_bf16(PAF(2),VFR(2),o[0],0,0,0), C1,0); \
    KRD(GL,3); GAPB(o[1]=__builtin_amdgcn_mfma_f32_32x32x16_bf16(PAF(2),VFR(6),o[1],0,0,0), C1,4); \
    GAPB(o[0]=__builtin_amdgcn_mfma_f32_32x32x16_bf16(PAF(3),VFR(3),o[0],0,0,0), C1,8); \
    GAPB(o[1]=__builtin_amdgcn_mfma_f32_32x32x16_bf16(PAF(3),VFR(7),o[1],0,0,0), C1,12); \
    }while(0)
  int t=1;
  #undef CMASK
  #define CMASK(P0,P1,t) do{}while(0)
  for(;t+5<NT;t+=2){
    STEP(pB0,pB1,pA0,pA1,t,true,true,true);     WAIT_BAR(2); RESC(); ROT();
    STEP(pA0,pA1,pB0,pB1,t+1,true,true,true);   WAIT_BAR(2); RESC(); ROT();
  }
  #undef CMASK
  #define CMASK(P0,P1,t) do{int jb_=(t)-(NT-4); if(jb_>=0)cmask(P0,P1,jb_,qrel,hi);}while(0)
  #define ENDW(tt) do{ if((tt)+3<NT){WAIT_BAR(2);} else if((tt)+2<NT){WAIT_BAR(1);} else {WAIT_BAR(0);} }while(0)
  for(;t+1<NT;t+=2){
    STEP(pB0,pB1,pA0,pA1,t,(t+3<NT),(t+1<NT),(t+1<NT));       ENDW(t);   RESC(); ROT();
    STEP(pA0,pA1,pB0,pB1,t+1,(t+4<NT),(t+2<NT),(t+2<NT));     ENDW(t+1); RESC(); ROT();
  }
  STEP(pB0,pB1,pA0,pA1,NT-1,false,false,false); RESC();
  { float sacc=pB0[0]+pB0[1]; _Pragma("unroll") for(int r=2;r<16;++r)sacc+=pB0[r]; _Pragma("unroll") for(int r=0;r<16;++r)sacc+=pB1[r]; l_reg+=sacc;
    pw0=(u32x4){PKW(pB0,0),PKW(pB0,2),PKW(pB0,4),PKW(pB0,6)};pw1=(u32x4){PKW(pB0,8),PKW(pB0,10),PKW(pB0,12),PKW(pB0,14)};pw2=(u32x4){PKW(pB1,0),PKW(pB1,2),PKW(pB1,4),PKW(pB1,6)};pw3=(u32x4){PKW(pB1,8),PKW(pB1,10),PKW(pB1,12),PKW(pB1,14)};
    SBAR(); pv(o,vb0+sl_cur,PAF(0),PAF(1),PAF(2),PAF(3)); }
  #undef PKW
  #undef PAF
  #undef VFR
  #undef PIN
  #undef MX3
  #undef GAPA
  #undef GAPB
  #undef EX
  #undef VRD
  #undef KRD
  #undef STEP
  #undef ENDW
  {auto rr=__builtin_amdgcn_permlane32_swap(__float_as_uint(l_reg),__float_as_uint(l_reg),false,false);l_reg=__uint_as_float(rr[0])+__uint_as_float(rr[1]);}
  if(hi==0)wsf[32+r32]=l_reg;asm volatile("s_waitcnt lgkmcnt(0)":::"memory");
  float rli[16];
  #pragma unroll
  for(int r=0;r<16;++r)rli[r]=__builtin_amdgcn_rcpf(wsf[32+crow(r,hi)]);
  bf16*Ow=O+(rowbase+q0+wid*QBLK)*ODM+h*D; const bf16*Gw=Gt+(rowbase+q0+wid*QBLK)*DM+h*D;
  { bf16*stg=(bf16*)(shm+LDS_OST)+wid*2048;
    #pragma unroll
    for(int r=0;r<16;++r){const int orow=crow(r,hi);
      #pragma unroll
      for(int d0=0;d0<2;++d0)stg[orow*64+d0*32+r32]=__float2bfloat16(o[d0][r]*rli[r]);}
    asm volatile("s_waitcnt lgkmcnt(0)":::"memory");
    #pragma unroll
    for(int i=0;i<4;++i){const int row=i*8+(lane>>3),ch=lane&7; u32x4 v=*(const u32x4*)(stg+row*64+ch*8); const u32x4 g=*(const u32x4*)(Gw+(long)row*DM+ch*8);
      #pragma unroll
      for(int e=0;e<4;++e)v[e]=cvtpk_s(__uint_as_float(v[e]<<16)*__uint_as_float(g[e]<<16),__uint_as_float(v[e]&0xffff0000u)*__uint_as_float(g[e]&0xffff0000u));
      ATTN_STORE16(Ow+(long)row*ODM+ch*8,v);} }
  asm volatile("s_waitcnt lgkmcnt(0)\n\ts_barrier":::"memory");
  #undef CINIT
  #undef DMA_K
  #undef DMA_V
  #undef CMASK
  #undef START
  #undef RESC
  #undef ROT
}
constexpr int ATTN_LDS_BYTES=LDS_BYTES;
#undef SBAR
#undef WAIT_BAR
}

__device__ __forceinline__ void p0_mod_item(int item, const Params& p, float* MOD, float* lds) {
    int tid = threadIdx.x; asm volatile("" : "+v"(tid));
    const int l = item / 48, n0 = (item % 48) * 64;
    float* sc = lds;
    float* red = lds + 4096;
    for (int i = tid; i < 4096; i += NTHREADS) sc[i] = silu_f(p.c[i]);
    __syncthreads();
    const int nl = tid & 63, ks = tid >> 6;
    float a0 = 0.f, a1 = 0.f, a2 = 0.f, a3 = 0.f;
    const float* w = p.ada_w + ((size_t)l * 1024 + ks * 128) * 3072 + n0 + nl;
#pragma unroll 8
    for (int k = 0; k < 128; ++k) {
        const float wv = w[(size_t)k * 3072]; const int kk = ks * 128 + k;
        a0 += sc[kk] * wv; a1 += sc[1024 + kk] * wv; a2 += sc[2048 + kk] * wv; a3 += sc[3072 + kk] * wv;
    }
    red[(ks * 4 + 0) * 64 + nl] = a0; red[(ks * 4 + 1) * 64 + nl] = a1; red[(ks * 4 + 2) * 64 + nl] = a2; red[(ks * 4 + 3) * 64 + nl] = a3;
    __syncthreads();
    if (tid < 256) {
        const int b = tid >> 6; float s = p.ada_b[l * 3072 + n0 + nl];
#pragma unroll
        for (int k = 0; k < 8; ++k) s += red[(k * 4 + b) * 64 + nl];
        MOD[(size_t)(l * 4 + b) * 3072 + n0 + nl] = s;
    }
    __syncthreads();
}
__device__ __forceinline__ void p0_tr_item(const float* W, int ldn, int k0, int csrc0, bf16_t* WT, int n0, float* tile) {
    int tid = threadIdx.x; asm volatile("" : "+v"(tid));
    {
        const int r = tid >> 6, cc = tid & 63;
#pragma unroll
        for (int i = 0; i < 8; ++i) { const int k = r + 8 * i; tile[k * 65 + cc] = W[(size_t)(k0 + k) * ldn + csrc0 + cc]; }
    }
    __syncthreads();
    {
        const int n = tid >> 3, kc = tid & 7;
        const float* s = tile + (kc * 8) * 65 + n;
        uint4 o; o.x = pk2(s[0], s[65]); o.y = pk2(s[2 * 65], s[3 * 65]); o.z = pk2(s[4 * 65], s[5 * 65]); o.w = pk2(s[6 * 65], s[7 * 65]);
        *(uint4*)(WT + (size_t)(n0 + n) * 1024 + k0 + kc * 8) = o;
    }
    __syncthreads();
}
__device__ __forceinline__ void p0_prologue(const Params& p, float* lds) {
    unsigned char* ws = p.ws;
    float* MOD = (float*)(ws + WS_MOD);
    const int G = gridDim.x, blk = blockIdx.x; int tid = threadIdx.x; asm volatile("" : "+v"(tid));
    constexpr int N_MOD = 96, N_WIN = 2 * 16 * 52, N_WOUT = 2 * 16 * 16;
    for (int it = blk; it < N_MOD + N_WIN + N_WOUT; it += G) {
        if (it < N_MOD) { p0_mod_item(it, p, MOD, lds); continue; }
        int r = it - N_MOD;
        if (r < N_WIN) {
            const int l = r / (16 * 52), q = r % (16 * 52), kb = q / 52, nb = q % 52;
            const int n0 = nb * 64, csrc0 = n0 + (n0 >= FCOL ? 8 : 0);
            p0_tr_item(p.w_in + (size_t)l * 1024 * DIN, DIN, kb * 64, csrc0, (bf16_t*)(ws + WS_WINT + l * WS_WINT_STRIDE), n0, lds);
            continue;
        }
        r -= N_WIN;
        { const int l = r / 256, q = r % 256, kb = q / 16, nb = q % 16;
          p0_tr_item(p.w_out + (size_t)l * 1024 * 1024, 1024, kb * 64, nb * 64, (bf16_t*)(ws + WS_WOUTT + (size_t)l * 2 * MiB), nb * 64, lds); }
    }
    const int gt = blk * NTHREADS + tid, GT = G * NTHREADS;
    bf16_t* SGW = (bf16_t*)(ws + WS_SGW);
    for (int i = gt; i < 2 * 4 * 128 * 128; i += GT) { const int s = i & 127, t = (i >> 7) & 127; SGW[i] = (bf16_t)(s <= t ? f2bf(p.sg_w[i]) : 0u); }
    bf16_t* WAT = (bf16_t*)(ws + WS_WAT);
    for (int i = gt; i < 2 * 2 * 4 * 64 * 64; i += GT) {
        const int ii = i & 63, j = (i >> 6) & 63, g = (i >> 12) & 3, mat = (i >> 14) & 1, l = i >> 15;
        const float* src = mat ? p.lru_wx : p.lru_wa;
        WAT[i] = (bf16_t)f2bf(src[((size_t)(l * 4 + g) * 64 + ii) * 64 + j]);
    }
}

template <bool FIRST, bool NEXT>
__device__ __forceinline__ void row_pass(const Params& p, int lprev, int ln, const float* xres, float* xout, float* lds) {
    unsigned char* ws = p.ws;
    int tid = threadIdx.x; asm volatile("" : "+v"(tid)); const int lane = tid & 63, wave = tid >> 6;
    const float* MOD = (const float*)(ws + WS_MOD);
    const bf16_t* YOUT = (const bf16_t*)(ws + WS_YOUT);
    bf16_t* H = (bf16_t*)(ws + WS_H);
    float* LS = (float*)(ws + WS_LS);
    float* wfl = lds;
    if (NEXT) {
        for (int i = tid; i < 8192; i += NTHREADS) { const int cc = i >> 3, jj = i & 7; wfl[jj * 1024 + cc] = p.w_in[((size_t)ln * 1024 + cc) * DIN + FCOL + jj]; }
        __syncthreads();
    }
    const int gw = blockIdx.x * 8 + wave, NGW = gridDim.x * 8;
    for (int row = gw; row < MROWS; row += NGW) {
        const int b = row >> 12;
        f32x4 xv[4];
#pragma unroll
        for (int j = 0; j < 4; ++j) xv[j] = *(const f32x4*)(xres + (size_t)row * DM + j * 256 + lane * 4);
        if (!FIRST) {
            f32x4 yv[4]; float ss = 0.f;
#pragma unroll
            for (int j = 0; j < 4; ++j) {
                const uint2 w = *(const uint2*)(YOUT + (size_t)row * DM + j * 256 + lane * 4);
                yv[j] = (f32x4){bflo(w.x), bfhi(w.x), bflo(w.y), bfhi(w.y)};
                ss += (yv[j].x * yv[j].x + yv[j].y * yv[j].y) + (yv[j].z * yv[j].z + yv[j].w * yv[j].w);
            }
            const float rinv = rsqrtf(wave_sum(ss) * (1.f / DM) + EPS);
            const float* gate = MOD + (size_t)(lprev * 4 + b) * 3072 + 2048;
#pragma unroll
            for (int j = 0; j < 4; ++j) {
                const f32x4 pg = *(const f32x4*)(p.post_g + lprev * DM + j * 256 + lane * 4);
                const f32x4 gt = *(const f32x4*)(gate + j * 256 + lane * 4);
                xv[j] = xv[j] + gt * ((yv[j] * rinv) * pg);
                *(f32x4*)(xout + (size_t)row * DM + j * 256 + lane * 4) = xv[j];
            }
        }
        if (NEXT) {
            float ss = 0.f;
#pragma unroll
            for (int j = 0; j < 4; ++j) ss += (xv[j].x * xv[j].x + xv[j].y * xv[j].y) + (xv[j].z * xv[j].z + xv[j].w * xv[j].w);
            const float rinv = rsqrtf(wave_sum(ss) * (1.f / DM) + EPS);
            const float* shift = MOD + (size_t)(ln * 4 + b) * 3072;
            const float* scale = shift + 1024;
            float fl[8];
#pragma unroll
            for (int jj = 0; jj < 8; ++jj) fl[jj] = 0.f;
#pragma unroll
            for (int j = 0; j < 4; ++j) {
                const int c0 = j * 256 + lane * 4;
                const f32x4 pg = *(const f32x4*)(p.pre_g + ln * DM + c0);
                const f32x4 sh = *(const f32x4*)(shift + c0);
                const f32x4 sc = *(const f32x4*)(scale + c0);
                const f32x4 hv = ((xv[j] * rinv) * pg) * (sc + 1.0f) + sh;
                uint2 o; o.x = pk2(hv.x, hv.y); o.y = pk2(hv.z, hv.w);
                *(uint2*)(H + (size_t)row * DM + c0) = o;
#pragma unroll
                for (int jj = 0; jj < 8; ++jj) { const f32x4 wv = *(const f32x4*)(wfl + jj * 1024 + c0); fl[jj] += (hv.x * wv.x + hv.y * wv.y) + (hv.z * wv.z + hv.w * wv.w); }
                asm volatile("" ::: "memory");
            }
#pragma unroll
            for (int jj = 0; jj < 8; ++jj) fl[jj] = wave_sum(fl[jj]);
            float mine = fl[0];
#pragma unroll
            for (int jj = 1; jj < 8; ++jj) mine = (lane == jj) ? fl[jj] : mine;
            if (lane < 8) {
                const float z = mine + p.b_f[ln * 8 + lane];
                const float lsg = fminf(z, 0.f) - log1pf(__expf(-fabsf(z)));
                LS[((size_t)(b * 8 + lane)) * SEQ + (row & (SEQ - 1))] = lsg * LOG2E;
            }
        }
    }
    __syncthreads();
}

template <class Store>
__device__ __forceinline__ void gemm_naive(const bf16_t* A, const bf16_t* Bt, int N, float* lds, const Store& st) {
    float* As = lds; float* Bs = lds + 32 * 68;
    int tid = threadIdx.x; asm volatile("" : "+v"(tid)); const int ntn = N / 64, ntiles = (MROWS / 64) * ntn;
    const int r = tid >> 3, kq = tid & 7, ty = tid >> 4, tx = tid & 15;
    for (int tile = blockIdx.x; tile < ntiles; tile += gridDim.x) {
        const int tm = tile / ntn, tn = tile % ntn;
        float acc[2][4];
#pragma unroll
        for (int i = 0; i < 2; ++i)
#pragma unroll
            for (int j = 0; j < 4; ++j) acc[i][j] = 0.f;
        for (int k0 = 0; k0 < 1024; k0 += 32) {
            const uint2 av = *(const uint2*)(A + (size_t)(tm * 64 + r) * 1024 + k0 + kq * 4);
            const uint2 bv = *(const uint2*)(Bt + (size_t)(tn * 64 + r) * 1024 + k0 + kq * 4);
            As[(kq * 4 + 0) * 68 + r] = bflo(av.x); As[(kq * 4 + 1) * 68 + r] = bfhi(av.x); As[(kq * 4 + 2) * 68 + r] = bflo(av.y); As[(kq * 4 + 3) * 68 + r] = bfhi(av.y);
            Bs[(kq * 4 + 0) * 68 + r] = bflo(bv.x); Bs[(kq * 4 + 1) * 68 + r] = bfhi(bv.x); Bs[(kq * 4 + 2) * 68 + r] = bflo(bv.y); Bs[(kq * 4 + 3) * 68 + r] = bfhi(bv.y);
            __syncthreads();
#pragma unroll 8
            for (int k = 0; k < 32; ++k) {
                const float2 a = *(const float2*)&As[k * 68 + ty * 2];
                const float4 bq = *(const float4*)&Bs[k * 68 + tx * 4];
                acc[0][0] += a.x * bq.x; acc[0][1] += a.x * bq.y; acc[0][2] += a.x * bq.z; acc[0][3] += a.x * bq.w;
                acc[1][0] += a.y * bq.x; acc[1][1] += a.y * bq.y; acc[1][2] += a.y * bq.z; acc[1][3] += a.y * bq.w;
            }
            __syncthreads();
        }
#pragma unroll
        for (int i = 0; i < 2; ++i)
#pragma unroll
            for (int j = 0; j < 4; ++j) st(tm * 64 + ty * 2 + i, tn * 64 + tx * 4 + j, acc[i][j]);
    }
}
struct StoreProj { ProjOut P; __device__ __forceinline__ void operator()(int row, int n, float v) const { proj_store(P, row, n, v); } };
struct StoreBf16 { bf16_t* O; int ld; __device__ __forceinline__ void operator()(int row, int n, float v) const { O[(size_t)row * ld + n] = (bf16_t)f2bf(v); } };

__device__ __forceinline__ void fk_cumsum(const float* LSbh, int n, unsigned char* shm) {
    int tid = threadIdx.x; asm volatile("" : "+v"(tid));
    float* fk = (float*)(shm + attn_body::LDS_FK); float* s0 = fk + SEQ; float* s1 = s0 + 512;
    const int t0 = tid * 8;
    f32x4 a = (f32x4){0.f, 0.f, 0.f, 0.f}, b = a;
    if (t0 < n) { a = *(const f32x4*)(LSbh + t0); b = *(const f32x4*)(LSbh + t0 + 4); }
    a.y += a.x; a.z += a.y; a.w += a.z; b.x += a.w; b.y += b.x; b.z += b.y; b.w += b.z;
    const float run = b.w;
    s0[tid] = run;
    __syncthreads();
    float* src = s0; float* dst = s1;
    for (int off = 1; off < 512; off <<= 1) {
        float t = src[tid]; if (tid >= off) t += src[tid - off];
        dst[tid] = t;
        __syncthreads();
        float* tmp = src; src = dst; dst = tmp;
    }
    const float excl = src[tid] - run;
    if (t0 < n) { *(f32x4*)(fk + t0) = a + excl; *(f32x4*)(fk + t0 + 4) = b + excl; }
    __syncthreads();
}

__device__ __forceinline__ void lru_item(int item, int layer, const Params& p, unsigned char* ldsb) {
    unsigned char* ws = p.ws;
    int tid = threadIdx.x; asm volatile("" : "+v"(tid)); const int lane = tid & 63, wave = tid >> 6;
    const int b = item >> 7, c = item & 127, t0 = c * 32; const size_t r0 = (size_t)b * SEQ + t0;
    const bf16_t* XLRU = (const bf16_t*)(ws + WS_XLRU);
    const bf16_t* GLRU = (const bf16_t*)(ws + WS_GLRU);
    const bf16_t* WAT = (const bf16_t*)(ws + WS_WAT);
    float* AGG = (float*)(ws + WS_AGG) + (size_t)layer * (4 * 128 * 2 * 256);
    unsigned* flags = (unsigned*)(ws + WS_FLAGS) + layer * 512;
    bf16_t* Y = (bf16_t*)(ws + WS_Y);
    bf16_t* xcb = (bf16_t*)ldsb;
    float* aL = (float*)(ldsb + 32 * 264 * 2);
    float* bL = aL + 32 * 256;
    float* ex = bL + 32 * 256;
    float* fold = ex + 4 * 256;
    {
        const int ch = (tid & 127) * 2, tq = tid >> 7;
        float w0[4], w1[4];
#pragma unroll
        for (int k = 0; k < 4; ++k) { w0[k] = p.conv_w[(layer * 4 + k) * 256 + ch]; w1[k] = p.conv_w[(layer * 4 + k) * 256 + ch + 1]; }
        const float cb0 = p.conv_b[layer * 256 + ch], cb1 = p.conv_b[layer * 256 + ch + 1];
        float xa[11], xb[11];
#pragma unroll
        for (int i = 0; i < 11; ++i) {
            const int t = t0 + tq * 8 - 3 + i;
            unsigned w = 0u;
            if (t >= 0) w = *(const unsigned*)(XLRU + ((size_t)b * SEQ + t) * 256 + ch);
            xa[i] = bflo(w); xb[i] = bfhi(w);
        }
#pragma unroll
        for (int i = 0; i < 8; ++i) {
            const float y0 = cb0 + w0[0] * xa[i] + w0[1] * xa[i + 1] + w0[2] * xa[i + 2] + w0[3] * xa[i + 3];
            const float y1 = cb1 + w1[0] * xb[i] + w1[1] * xb[i + 1] + w1[2] * xb[i + 2] + w1[3] * xb[i + 3];
            *(unsigned*)(xcb + (tq * 8 + i) * 264 + ch) = pk2(y0, y1);
        }
    }
    __syncthreads();
    {
        const int g = wave >> 1, jh = wave & 1, l31 = lane & 31, hi = lane >> 5;
        const int j = jh * 32 + l31, ch = g * 64 + j;
        f32x16 accR = {}, accI = {};
#pragma unroll
        for (int kb = 0; kb < 4; ++kb) {
            const bf16x8 af = *(const bf16x8*)(xcb + l31 * 264 + g * 64 + kb * 16 + hi * 8);
            const bf16x8 br = *(const bf16x8*)(WAT + ((size_t)((layer * 2 + 0) * 4 + g) * 64 + j) * 64 + kb * 16 + hi * 8);
            const bf16x8 bi = *(const bf16x8*)(WAT + ((size_t)((layer * 2 + 1) * 4 + g) * 64 + j) * 64 + kb * 16 + hi * 8);
            accR = __builtin_amdgcn_mfma_f32_32x32x16_bf16(af, br, accR, 0, 0, 0);
            accI = __builtin_amdgcn_mfma_f32_32x32x16_bf16(af, bi, accI, 0, 0, 0);
        }
        const float ba = p.lru_ba[layer * 256 + ch], bx = p.lru_bx[layer * 256 + ch], lam = p.lru_lambda[layer * 256 + ch];
        const float sp = fmaxf(-lam, 0.f) + log1pf(__expf(-fabsf(lam)));
#pragma unroll
        for (int r = 0; r < 16; ++r) {
            const int t = crow(r, hi);
            const float rg = sigmoid_f(accR[r] + ba), ig = sigmoid_f(accI[r] + bx);
            const float a = __expf(-8.0f * rg * sp);
            const float xc = bf2f(xcb[t * 264 + ch]);
            const float bt = __builtin_amdgcn_sqrtf(fmaxf(1.f - a * a, 0.f)) * (ig * xc);
            aL[t * 256 + ch] = a; bL[t * 256 + ch] = bt;
            if ((r & 3) == 3) asm volatile("" ::: "memory");
        }
    }
    __syncthreads();
    {
        const int ch = tid & 255, half = tid >> 8;
        float hl[16], ca[16]; float hloc = 0.f, cum = 1.f;
#pragma unroll
        for (int i = 0; i < 16; ++i) { const int t = half * 16 + i; const float a = aL[t * 256 + ch], bt = bL[t * 256 + ch]; hloc = a * hloc + bt; cum *= a; hl[i] = hloc; ca[i] = cum; }
        ex[(half * 2 + 0) * 256 + ch] = cum; ex[(half * 2 + 1) * 256 + ch] = hloc;
        __syncthreads();
        if (half == 0) {
            const float A1 = ex[(2 + 0) * 256 + ch], H1 = ex[(2 + 1) * 256 + ch];
            AGG[((size_t)(b * 128 + c) * 2 + 0) * 256 + ch] = cum * A1;
            AGG[((size_t)(b * 128 + c) * 2 + 1) * 256 + ch] = A1 * hloc + H1;
        }
        asm volatile("s_waitcnt vmcnt(0)" ::: "memory");
        __syncthreads();
        if (tid == 0) {
            __builtin_amdgcn_fence(__ATOMIC_RELEASE, "agent");
            asm volatile("s_waitcnt vmcnt(0)" ::: "memory");
            __hip_atomic_store(flags + item, 1u, __ATOMIC_RELAXED, __HIP_MEMORY_SCOPE_AGENT);
        }
        if (tid < c) {
            unsigned* f = flags + (item - c) + tid; unsigned sp = 0u;
            while (__hip_atomic_load(f, __ATOMIC_RELAXED, __HIP_MEMORY_SCOPE_AGENT) == 0u) { __builtin_amdgcn_s_sleep(2); if (++sp > (1u << 22)) break; }
        }
        __syncthreads();
        if (tid == 0) { __builtin_amdgcn_fence(__ATOMIC_ACQUIRE, "agent"); asm volatile("s_waitcnt vmcnt(0)" ::: "memory"); }
        __syncthreads();
        {
            const int q4 = (tid & 63) * 4, seg = tid >> 6, per = (c + 7) >> 3, lo = seg * per, hi2 = (lo + per < c) ? lo + per : c;
            f32x4 Ac = (f32x4){1.f, 1.f, 1.f, 1.f}, Hc = (f32x4){0.f, 0.f, 0.f, 0.f};
#pragma unroll 4
            for (int cc = lo; cc < hi2; ++cc) {
                const f32x4 a4 = *(const f32x4*)(AGG + ((size_t)(b * 128 + cc) * 2 + 0) * 256 + q4), h4 = *(const f32x4*)(AGG + ((size_t)(b * 128 + cc) * 2 + 1) * 256 + q4);
                Hc = a4 * Hc + h4; Ac = Ac * a4;
            }
            *(f32x4*)(fold + (seg * 2 + 0) * 256 + q4) = Ac; *(f32x4*)(fold + (seg * 2 + 1) * 256 + q4) = Hc;
        }
        __syncthreads();
        float carry = 0.f;
#pragma unroll
        for (int sgm = 0; sgm < 8; ++sgm) carry = fold[(sgm * 2 + 0) * 256 + ch] * carry + fold[(sgm * 2 + 1) * 256 + ch];
        if (half == 1) carry = ex[0 * 256 + ch] * carry + ex[1 * 256 + ch];
#pragma unroll
        for (int i = 0; i < 16; ++i) {
            const int t = half * 16 + i; const size_t row = r0 + t;
            const float hv = hl[i] + ca[i] * carry;
            const float gs = bf2f(GLRU[row * 256 + ch]);
            Y[row * 1024 + 512 + ch] = (bf16_t)f2bf(hv * gs);
            if ((i & 7) == 7) asm volatile("" ::: "memory");
        }
    }
    __syncthreads();
}

__device__ __forceinline__ void sg_item(int item, int layer, const Params& p, unsigned char* ldsb) {
    unsigned char* ws = p.ws;
    int tid = threadIdx.x; asm volatile("" : "+v"(tid)); const int lane = tid & 63, wave = tid >> 6;
    const int g = item & 3; const size_t r0 = (size_t)(item >> 2) * 128;
    const bf16_t* SGU = (const bf16_t*)(ws + WS_SGU);
    const bf16_t* SGV = (const bf16_t*)(ws + WS_SGV);
    const bf16_t* GSG = (const bf16_t*)(ws + WS_GSG);
    const bf16_t* SGW = (const bf16_t*)(ws + WS_SGW);
    bf16_t* Y = (bf16_t*)(ws + WS_Y);
    bf16_t* vn = (bf16_t*)ldsb;
    {
        const f32x4 lg = *(const f32x4*)(p.sg_ln_g + layer * 256 + lane * 4), lb = *(const f32x4*)(p.sg_ln_b + layer * 256 + lane * 4);
#pragma unroll 4
        for (int i = 0; i < 16; ++i) {
            const int t = wave * 16 + i;
            const uint2 w = *(const uint2*)(SGV + (r0 + t) * 256 + lane * 4);
            f32x4 v = (f32x4){bflo(w.x), bfhi(w.x), bflo(w.y), bfhi(w.y)};
            const float mu = wave_sum((v.x + v.y) + (v.z + v.w)) * (1.f / 256.f);
            v = v - mu;
            const float var = wave_sum((v.x * v.x + v.y * v.y) + (v.z * v.z + v.w * v.w)) * (1.f / 256.f);
            const float rs = rsqrtf(var + EPS);
            v = (v * rs) * lg + lb;
            uint2 o; o.x = pk2(v.x, v.y); o.y = pk2(v.z, v.w);
            if ((lane >> 4) == g) *(uint2*)(vn + t * 68 + (lane & 15) * 4) = o;
        }
    }
    __syncthreads();
    {
        const int tt = wave >> 1, dh = wave & 1, l31 = lane & 31, hi = lane >> 5;
        const int d = dh * 32 + l31, ch = g * 64 + d;
        f32x16 acc = (f32x16){};
        const bf16_t* Wg = SGW + (size_t)(layer * 4 + g) * 128 * 128;
        const int nkb = 2 * tt + 2;
        for (int kb = 0; kb < nkb; ++kb) {
            bf16x8 bfr;
#pragma unroll
            for (int i = 0; i < 8; ++i) bfr[i] = (short)vn[(kb * 16 + hi * 8 + i) * 68 + d];
            const bf16x8 af = *(const bf16x8*)(Wg + (size_t)(tt * 32 + l31) * 128 + kb * 16 + hi * 8);
            acc = __builtin_amdgcn_mfma_f32_32x32x16_bf16(af, bfr, acc, 0, 0, 0);
        }
#pragma unroll
        for (int r = 0; r < 16; ++r) {
            const int t = tt * 32 + crow(r, hi); const size_t row = r0 + t;
            const float z = acc[r] + p.sg_b[(layer * 4 + g) * 128 + t];
            const float u = bf2f(SGU[row * 256 + ch]), gs = bf2f(GSG[row * 256 + ch]);
            Y[row * 1024 + 768 + ch] = (bf16_t)f2bf(u * z * gs);
            if ((r & 7) == 7) asm volatile("" ::: "memory");
        }
    }
    __syncthreads();
}

#define LAS __attribute__((address_space(3)))
#define XB_TMO      128
#define XB_XCNT(j)  (256  + 64 * (j))
#define XB_XSUB(j)  (1280 + 64 * (j))
#define XB_XGEN(j)  (2304 + 64 * (j))
#define XB_TOP      3328
#define XB_TOPGEN   3392
#define XCD_BAR_WORDS 3456
#define XB_SPIN_CAP (1u << 18)

__device__ __forceinline__ unsigned xb_ld(unsigned* p)              { return __hip_atomic_load(p, __ATOMIC_RELAXED, __HIP_MEMORY_SCOPE_AGENT); }
__device__ __forceinline__ unsigned xb_add(unsigned* p, unsigned v) { return __hip_atomic_fetch_add(p, v, __ATOMIC_RELAXED, __HIP_MEMORY_SCOPE_AGENT); }
__device__ __forceinline__ unsigned xb_xcc_id() { return (unsigned)__builtin_amdgcn_s_getreg((3 << 11) | 20) & 0xFu; }
#define XB_SPIN(cond, bar) do { unsigned _sp = 0; while (cond) { __builtin_amdgcn_s_sleep(1); \
    if ((++_sp & 255u) == 0u) { if (xb_ld(&(bar)[XB_TMO])) break; if (_sp > XB_SPIN_CAP) { atomicAdd(&(bar)[XB_TMO], 1u); break; } } } } while (0)

struct XcdBarrier {
    unsigned* bar; unsigned x;
    volatile LAS unsigned* st;
};

__device__ __forceinline__ XcdBarrier xcd_barrier_post(unsigned* bar, volatile LAS unsigned* st) {
    XcdBarrier b; b.bar = bar; b.x = xb_xcc_id(); b.st = st;
    if (threadIdx.x == 0) (void)xb_add(&bar[XB_XCNT(b.x)], 1u);
    return b;
}
__device__ __forceinline__ void xcd_barrier_complete(unsigned* bar, unsigned x, unsigned& nloc, unsigned& nx) {
    const unsigned G = gridDim.x * gridDim.y * gridDim.z;
    unsigned sum, cnt, mine, sp = 0u;
    for (;;) {
        sum = 0u; cnt = 0u; mine = 0u;
#pragma unroll
        for (unsigned j = 0; j < 16; ++j) { const unsigned c = xb_ld(&bar[XB_XCNT(j)]); sum += c; cnt += (c > 0u) ? 1u : 0u; mine = (j == x) ? c : mine; }
        if (sum == G) break;
        __builtin_amdgcn_s_sleep(1);
        if ((++sp & 255u) == 0u) { if (xb_ld(&bar[XB_TMO])) break; if (sp > XB_SPIN_CAP) { atomicAdd(&bar[XB_TMO], 1u); break; } }
    }
    nloc = mine > 0u ? mine : 1u; nx = cnt > 0u ? cnt : 1u;
}

__device__ __forceinline__ void xcd_barrier(const XcdBarrier& b) {
    asm volatile("s_waitcnt vmcnt(0)" ::: "memory");
    __syncthreads();
    if (threadIdx.x == 0) {
        unsigned* bar = b.bar;
        __builtin_amdgcn_s_waitcnt(0);
        unsigned nloc = b.st[0], nx = b.st[1];
        if (nloc == 0u) { xcd_barrier_complete(bar, b.x, nloc, nx); b.st[0] = nloc; b.st[1] = nx; }
        const unsigned old = xb_add(&bar[XB_XSUB(b.x)], 1u);
        const unsigned gen = old / nloc;
        if (old + 1u == (gen + 1u) * nloc) {
            __builtin_amdgcn_fence(__ATOMIC_RELEASE, "agent");
            asm volatile("s_waitcnt vmcnt(0)" ::: "memory");
            const unsigned og = xb_add(&bar[XB_TOP], 1u);
            const unsigned tg = og / nx;
            if (og + 1u == (tg + 1u) * nx) xb_add(&bar[XB_TOPGEN], 1u);
            else XB_SPIN(xb_ld(&bar[XB_TOPGEN]) == tg, bar);
            __builtin_amdgcn_fence(__ATOMIC_ACQUIRE, "agent");
            xb_add(&bar[XB_XGEN(b.x)], 1u);
            asm volatile("s_waitcnt vmcnt(0)" ::: "memory");
        } else {
            XB_SPIN(xb_ld(&bar[XB_XGEN(b.x)]) == gen, bar);
            __builtin_amdgcn_fence(__ATOMIC_ACQUIRE, "agent");
            asm volatile("s_waitcnt vmcnt(0)" ::: "memory");
        }
    }
    __syncthreads();
}

__global__ void __launch_bounds__(NTHREADS) fwd_megakernel(Params p) {
    extern __shared__ __attribute__((aligned(16))) unsigned char lds[];
    cg::grid_group grid = cg::this_grid();
    unsigned char* ws = p.ws;
    const int G = gridDim.x, blk = blockIdx.x;
    ProjOut PO{(bf16_t*)(ws + WS_Q), (bf16_t*)(ws + WS_K), (bf16_t*)(ws + WS_V), (bf16_t*)(ws + WS_GATT), (bf16_t*)(ws + WS_XLRU), (bf16_t*)(ws + WS_GLRU),
               (bf16_t*)(ws + WS_SGU), (bf16_t*)(ws + WS_SGV), (bf16_t*)(ws + WS_GSG)};

    if (threadIdx.x < 8) ((LAS unsigned*)(lds + BARST_OFF))[threadIdx.x] = 0u;
    __syncthreads();
    const XcdBarrier xbar = xcd_barrier_post((unsigned*)(ws + WS_BAR), (volatile LAS unsigned*)(lds + BARST_OFF));
    p0_prologue(p, (float*)lds);
    grid.sync();
    row_pass<true, true>(p, 0, 0, p.x, nullptr, (float*)lds);
    xcd_barrier(xbar);
    for (int layer = 0; layer < NLAYER; ++layer) {
        { pg8::Gemm g{(const bf16_t*)(ws + WS_H), (const bf16_t*)(ws + WS_WINT + layer * WS_WINT_STRIDE), MROWS, NPROJ, DM}; pg8::StaticOrder S; S.init(MROWS, NPROJ, G, blk);
          pg8::EpiProj E{PO};
          pg8::gemm_phase<pg8::EpiProj, pg8::StaticOrder, true, true>((PG8_LAS unsigned char*)lds, g, S, E); }
        xcd_barrier(xbar);
        for (int it = blk; it < 512; it += G) lru_item(it, layer, p, lds);
        for (int it = blk; it < 512; it += G) sg_item(it, layer, p, lds);
        { const int vcu = (G % 8 == 0) ? (blk % 8) * (G / 8) + blk / 8 : blk;
          static_assert(attn_body::ATTN_LDS_BYTES <= 131072, "attention LDS");
          for (int v = vcu; v < 256; v += G) { const int bh = v >> 3, s = v & 7;
            fk_cumsum((const float*)(ws + WS_LS) + (size_t)bh * SEQ, (16 - s) * 256, lds);
            for (int i = 0; i < 2; ++i) attn_body::attn_unit<8, false>(bh >> 3, bh & 7, i == 0 ? 15 - s : s, (const attn_body::bf16*)(ws + WS_Q), (const attn_body::bf16*)(ws + WS_K), (const attn_body::bf16*)(ws + WS_V),
                (attn_body::bf16*)(ws + WS_Y), (const attn_body::bf16*)(ws + WS_GATT), nullptr, (char*)lds); }
          __syncthreads(); }
        xcd_barrier(xbar);
        { pg8::Gemm g{(const bf16_t*)(ws + WS_Y), (const bf16_t*)(ws + WS_WOUTT + (size_t)layer * 2 * MiB), MROWS, DM, DM}; pg8::StaticOrder S; S.init(MROWS, DM, G, blk);
          pg8::EpiBf16<0> E{(bf16_t*)(ws + WS_YOUT), DM, nullptr, 0, 0, 1.f};
          pg8::gemm_phase<pg8::EpiBf16<0>, pg8::StaticOrder, true, true>((PG8_LAS unsigned char*)lds, g, S, E); }
        xcd_barrier(xbar);
        if (layer == 0) { row_pass<false, true>(p, 0, 1, p.x, p.out, (float*)lds); xcd_barrier(xbar); }
        else row_pass<false, false>(p, 1, 1, p.out, p.out, (float*)lds);
    }
}

extern "C" void kernel_launch(void* const* d_in, const int* in_sizes, int n_in, void* d_out, int out_size, void* d_ws, size_t ws_size, hipStream_t stream) {
    static int grid = 0;
    if (grid == 0) {
        if (n_in != 20 || out_size != MROWS * DM || ws_size < WS_END) { fprintf(stderr, "kernel_launch: unexpected shapes (n_in %d out %d ws %zu)\n", n_in, out_size, ws_size); grid = -1; return; }
        int dev = 0, cus = 0, per_cu = 0;
        if (hipGetDevice(&dev) != hipSuccess || hipDeviceGetAttribute(&cus, hipDeviceAttributeMultiprocessorCount, dev) != hipSuccess) { grid = -1; return; }
        if (hipFuncSetAttribute((const void*)fwd_megakernel, hipFuncAttributeMaxDynamicSharedMemorySize, LDS_BYTES) != hipSuccess) { fprintf(stderr, "kernel_launch: hipFuncSetAttribute failed\n"); grid = -1; return; }
        if (hipOccupancyMaxActiveBlocksPerMultiprocessor(&per_cu, (const void*)fwd_megakernel, NTHREADS, LDS_BYTES) != hipSuccess || per_cu < 1) { fprintf(stderr, "kernel_launch: occupancy query says %d\n", per_cu); per_cu = 1; }
        (void)hipGetLastError();
        grid = cus;
    }
    if (grid < 0) return;
    if (hipMemsetAsync(d_ws, 0, 65536, stream) != hipSuccess) { fprintf(stderr, "kernel_launch: memset failed\n"); return; }
    Params p{};
    p.x = (const float*)d_in[0]; p.c = (const float*)d_in[1]; p.ada_w = (const float*)d_in[2]; p.ada_b = (const float*)d_in[3]; p.pre_g = (const float*)d_in[4];
    p.post_g = (const float*)d_in[5]; p.w_in = (const float*)d_in[6]; p.b_f = (const float*)d_in[7]; p.conv_w = (const float*)d_in[8]; p.conv_b = (const float*)d_in[9];
    p.lru_wa = (const float*)d_in[10]; p.lru_ba = (const float*)d_in[11]; p.lru_wx = (const float*)d_in[12]; p.lru_bx = (const float*)d_in[13]; p.lru_lambda = (const float*)d_in[14];
    p.sg_ln_g = (const float*)d_in[15]; p.sg_ln_b = (const float*)d_in[16]; p.sg_w = (const float*)d_in[17]; p.sg_b = (const float*)d_in[18]; p.w_out = (const float*)d_in[19];
    p.out = (float*)d_out; p.ws = (unsigned char*)d_ws;
    void* args[] = {&p};
    hipError_t e = hipLaunchCooperativeKernel((const void*)fwd_megakernel, dim3(grid), dim3(NTHREADS), args, LDS_BYTES, stream);
    if (e != hipSuccess) fprintf(stderr, "kernel_launch: cooperative launch failed: %s (grid %d)\n", hipGetErrorString(e), grid);
}
```

```cpp
#include <hip/hip_runtime.h>
#include <hip/hip_cooperative_groups.h>
#include <cstdio>
#include <cstdint>
namespace cg = cooperative_groups;

typedef unsigned short bf16_t;
typedef short bf16x8 __attribute__((ext_vector_type(8)));
typedef float f32x16 __attribute__((ext_vector_type(16)));
typedef float f32x4 __attribute__((ext_vector_type(4)));

constexpr int NB = 4, SEQ = 4096, DM = 1024, MROWS = NB * SEQ, NLAYER = 2;
constexpr int DIN = 3336, NPROJ = 3328, NPROJ_PAD = 3584;
constexpr int FCOL = 1536;
constexpr int NTHREADS = 512;
constexpr float EPS = 1e-6f;
constexpr float LOG2E = 1.4426950408889634f;
constexpr float QSCALE = 0.125f * LOG2E;

constexpr size_t MiB = 1u << 20;
constexpr size_t WS_WINT = 2 * MiB;
constexpr size_t WS_WINT_STRIDE = 7 * MiB;
constexpr size_t WS_WOUTT = 16 * MiB;
constexpr size_t WS_MOD = 20 * MiB;
constexpr size_t WS_SGW = 21 * MiB;
constexpr size_t WS_WAT = 22 * MiB;
constexpr size_t WS_LS = 23 * MiB;
constexpr size_t WS_FC = 24 * MiB;
constexpr size_t WS_AGG = 25 * MiB;
constexpr size_t WS_FLAGS = 32768;
constexpr size_t WS_H = 32 * MiB;
constexpr size_t WS_Q = 64 * MiB, WS_K = 80 * MiB, WS_V = 96 * MiB, WS_GATT = 112 * MiB;
constexpr size_t WS_XLRU = 128 * MiB, WS_GLRU = 136 * MiB, WS_SGU = 144 * MiB, WS_SGV = 152 * MiB, WS_GSG = 160 * MiB;
constexpr size_t WS_Y = 168 * MiB;
constexpr size_t WS_YOUT = 64 * MiB;
constexpr size_t WS_END = 200 * MiB;

constexpr int LDS_BYTES = 147456;
constexpr int BARST_OFF = 131072 + 320;
constexpr size_t WS_BAR = 16384;

struct Params {
    const float *x, *c, *ada_w, *ada_b, *pre_g, *post_g, *w_in, *b_f, *conv_w, *conv_b, *lru_wa, *lru_ba, *lru_wx, *lru_bx, *lru_lambda,
        *sg_ln_g, *sg_ln_b, *sg_w, *sg_b, *w_out;
    float* out; unsigned char* ws;
};

__device__ __forceinline__ unsigned f2bf(float f) { unsigned u = __float_as_uint(f); return (u + 0x7fffu + ((u >> 16) & 1u)) >> 16; }
__device__ __forceinline__ unsigned pk2(float lo, float hi) { return f2bf(lo) | (f2bf(hi) << 16); }
__device__ __forceinline__ float bf2f(unsigned h) { return __uint_as_float(h << 16); }
__device__ __forceinline__ float bflo(unsigned w) { return __uint_as_float(w << 16); }
__device__ __forceinline__ float bfhi(unsigned w) { return __uint_as_float(w & 0xffff0000u); }
__device__ __forceinline__ float wave_sum(float v) {
#pragma unroll
    for (int o = 1; o < 64; o <<= 1) v += __shfl_xor(v, o);
    return v;
}
__device__ __forceinline__ float sigmoid_f(float v) { return __builtin_amdgcn_rcpf(1.f + __expf(-v)); }
__device__ __forceinline__ float silu_f(float v) { return v * __builtin_amdgcn_rcpf(1.f + __expf(-v)); }
__device__ __forceinline__ float gelu_f(float v) { const float u = 1.5957691216057308f * (v + 0.044715f * v * v * v); return v * __builtin_amdgcn_rcpf(1.f + __expf(-u)); }
__device__ __forceinline__ int crow(int r, int hi) { return (r & 3) + 8 * (r >> 2) + 4 * hi; }

struct ProjOut { bf16_t *Q, *K, *V, *GATT, *XLRU, *GLRU, *SGU, *SGV, *GSG; };
__device__ __forceinline__ void proj_store(const ProjOut& P, int row, int n, float v) {
    if (n < 512) P.Q[(size_t)row * 512 + n] = (bf16_t)f2bf(v * QSCALE);
    else if (n < 1024) P.K[(size_t)row * 512 + n - 512] = (bf16_t)f2bf(v);
    else if (n < 1536) P.V[(size_t)row * 512 + n - 1024] = (bf16_t)f2bf(v);
    else if (n < 2048) P.GATT[(size_t)row * 512 + n - 1536] = (bf16_t)f2bf(silu_f(v));
    else if (n < 2304) P.XLRU[(size_t)row * 256 + n - 2048] = (bf16_t)f2bf(v);
    else if (n < 2560) P.GLRU[(size_t)row * 256 + n - 2304] = (bf16_t)f2bf(silu_f(v));
    else if (n < 2816) P.SGU[(size_t)row * 256 + n - 2560] = (bf16_t)f2bf(gelu_f(v));
    else if (n < 3072) P.SGV[(size_t)row * 256 + n - 2816] = (bf16_t)f2bf(gelu_f(v));
    else P.GSG[(size_t)row * 256 + n - 3072] = (bf16_t)f2bf(silu_f(v));
}

namespace pg8 {
#define PG8_LAS __attribute__((address_space(3)))
typedef unsigned short bf16_t;
typedef short bf16x8 __attribute__((ext_vector_type(8)));
typedef float f32x4 __attribute__((ext_vector_type(4)));
typedef unsigned u32x4 __attribute__((ext_vector_type(4)));
constexpr int BM = 256, BK = 64, HALF = 128, HTB = HALF * BK * 2  , STAGE_BYTES = 8 * HTB, NXCD = 8, WGM = 8;

__host__ __device__ __forceinline__ int lds_byte(int r, int c) { const int st = (r >> 4) * 2 + (c >> 5), rr = r & 15, cc = c & 31, ob = rr * 64 + cc * 2; return st * 1024 + (ob ^ (((ob >> 9) & 1) << 5)); }
__host__ __device__ __forceinline__ void stage_rc(int b, int& R, int& C) { const int st = b / 1024, sb = b % 1024, swz = sb ^ (((sb >> 9) & 1) << 5); R = (st >> 1) * 16 + swz / 64; C = (st & 1) * 32 + (swz % 64) / 2; }
__host__ __device__ __forceinline__ int perm32(int rho) { const int n = rho >> 4, i = rho & 15; return 8 * (i >> 2) + 4 * n + (i & 3); }

struct Unit { int pm, pn; };
struct Gemm { const bf16_t* A; const bf16_t* Bt; int M, N, K; };

struct StaticOrder {
    int nM, nN, nwg, G, c;
    __host__ __device__ void init(int M, int N, int G_, int c_) { nM = M / BM; nN = N / BM; nwg = nM * nN; G = G_; c = c_; }
    __host__ __device__ bool next(int i, Unit& u) const {
        const long L = (long)i * G + c; if (L >= nwg) return false;
        int wgid = (int)L; { const int q = nwg / NXCD, r = nwg % NXCD, xcd = wgid % NXCD, off = wgid / NXCD; wgid = (xcd < r ? xcd * (q + 1) : r * (q + 1) + (xcd - r) * q) + off; }
        const int nig = WGM * nN, gid = wgid / nig, fm = gid * WGM, gsz = (nM - fm) < WGM ? (nM - fm) : WGM;
        u.pm = fm + ((wgid % nig) % gsz); u.pn = (wgid % nig) / gsz; return true;
    }
    __device__ __forceinline__ void a_ready(const Unit&) const {}
    __device__ __forceinline__ void done(const Unit&) const {}
};

__device__ __forceinline__ unsigned cvt_pk_bf16(float lo, float hi) { unsigned r; asm volatile("v_cvt_pk_bf16_f32 %0, %1, %2" : "=v"(r) : "v"(lo), "v"(hi)); return r; }
typedef float f32x2 __attribute__((ext_vector_type(2)));
__device__ __forceinline__ f32x2 gelu_pk(f32x2 v) {
    const f32x2 av = __builtin_elementwise_abs(v), d = av * 0.2316418882f + 1.0f;
    f32x2 t; t.x = __builtin_amdgcn_rcpf(d.x); t.y = __builtin_amdgcn_rcpf(d.y);
    f32x2 q = t * 0.5307027145f + (-0.7265760135f); q = q * t + 0.7107068705f; q = q * t + (-0.142248368f); q = q * t + 0.127414796f; q = q * t;
    const f32x2 s = (v * v) * (-0.72134752044f);
    f32x2 e; e.x = __builtin_amdgcn_exp2f(s.x); e.y = __builtin_amdgcn_exp2f(s.y);
    const f32x2 m = v * (q * e), r = v - m;
    f32x2 o; o.x = v.x < 0.f ? m.x : r.x; o.y = v.y < 0.f ? m.y : r.y; return o;
}

template <int ACT  > struct EpiBf16 {
    static constexpr bool PERM = true, AFTER_DRAIN = false; static_assert(ACT == 0 || ACT == 1, "EpiBf16: ACT is 0 (none) or 1 (gelu_pk)");
    bf16_t* O; int ldc; const float* bias; int split_cols; size_t split_stride; float scale0;
    __device__ __forceinline__ void operator()(const f32x4 (&acc)[2][2][4][2], const Unit& u, int wr, int wc, int fr, int fq) const {
        const int row0 = u.pm * BM + wr * 64 + fr; int colt = u.pn * BM; bf16_t* base = O;
        float sc = 1.f; if (split_cols) { const int t = colt / split_cols; base += (size_t)t * split_stride; colt -= t * split_cols; if (t == 0) sc = scale0; }
        const int col0 = colt + wc * 32 + 8 * fq, bcol0 = u.pn * BM + wc * 32 + 8 * fq;
        f32x4 bv[2][2];
#pragma unroll
        for (int bj = 0; bj < 2; ++bj)
#pragma unroll
            for (int n = 0; n < 2; ++n) bv[bj][n] = bias ? *(const f32x4*)(bias + bcol0 + bj * HALF + 4 * n) : (f32x4){0.f, 0.f, 0.f, 0.f};
#pragma unroll
        for (int ai = 0; ai < 2; ++ai)
#pragma unroll
            for (int m = 0; m < 4; ++m) { bf16_t* rowp = base + (size_t)(row0 + ai * HALF + m * 16) * ldc + col0;
#pragma unroll
                for (int bj = 0; bj < 2; ++bj) { f32x4 v0 = acc[ai][bj][m][0] + bv[bj][0], v1 = acc[ai][bj][m][1] + bv[bj][1];
                    if (ACT == 1) { f32x2 a = gelu_pk((f32x2){v0[0], v0[1]}), b = gelu_pk((f32x2){v0[2], v0[3]}), c = gelu_pk((f32x2){v1[0], v1[1]}), d = gelu_pk((f32x2){v1[2], v1[3]});
                        v0 = (f32x4){a.x, a.y, b.x, b.y}; v1 = (f32x4){c.x, c.y, d.x, d.y}; }
                    v0 = v0 * sc; v1 = v1 * sc; u32x4 w; w.x = cvt_pk_bf16(v0[0], v0[1]); w.y = cvt_pk_bf16(v0[2], v0[3]); w.z = cvt_pk_bf16(v1[0], v1[1]); w.w = cvt_pk_bf16(v1[2], v1[3]);
                    *(u32x4*)(rowp + bj * HALF) = w; } }
    }
};

struct EpiProj {
    static constexpr bool PERM = true, AFTER_DRAIN = false;
    ::ProjOut P; const float* bfl; float* LS;
    __device__ __forceinline__ void operator()(const f32x4 (&acc)[2][2][4][2], const Unit& u, int wr, int wc, int fr, int fq) const {
        const int pn = u.pn;
        if (pn == 13) {
            if (wc == 0 && fq == 0) {
                const f32x4 b0 = *(const f32x4*)bfl, b1 = *(const f32x4*)(bfl + 4);
#pragma unroll
                for (int ai = 0; ai < 2; ++ai)
#pragma unroll
                    for (int m = 0; m < 4; ++m) { const int row = u.pm * BM + wr * 64 + fr + ai * HALF + m * 16, bb = row >> 12, t = row & 4095;
                        const f32x4 z0 = acc[ai][0][m][0] + b0, z1 = acc[ai][0][m][1] + b1;
#pragma unroll
                        for (int e = 0; e < 4; ++e) {
                            LS[(size_t)(bb * 8 + e) * 4096 + t] = (fminf(z0[e], 0.f) - log1pf(__expf(-fabsf(z0[e])))) * ::LOG2E;
                            LS[(size_t)(bb * 8 + 4 + e) * 4096 + t] = (fminf(z1[e], 0.f) - log1pf(__expf(-fabsf(z1[e])))) * ::LOG2E; } }
            }
            return;
        }
        bf16_t* base; int ldc = 512, colt = 0, act = 0; float sc = 1.f;
        if (pn < 2) { base = P.Q; colt = pn * 256; sc = ::QSCALE; }
        else if (pn < 4) { base = P.K; colt = (pn - 2) * 256; }
        else if (pn < 6) { base = P.V; colt = (pn - 4) * 256; }
        else if (pn < 8) { base = P.GATT; colt = (pn - 6) * 256; act = 1; }
        else { ldc = 256; base = (pn == 8) ? P.XLRU : (pn == 9) ? P.GLRU : (pn == 10) ? P.SGU : (pn == 11) ? P.SGV : P.GSG; act = (pn == 8) ? 0 : ((pn == 10 || pn == 11) ? 2 : 1); }
        const int row0 = u.pm * BM + wr * 64 + fr, col0 = colt + wc * 32 + 8 * fq;
#pragma unroll
        for (int ai = 0; ai < 2; ++ai)
#pragma unroll
            for (int m = 0; m < 4; ++m) { bf16_t* rowp = base + (size_t)(row0 + ai * HALF + m * 16) * ldc + col0;
#pragma unroll
                for (int bj = 0; bj < 2; ++bj) { f32x4 v0 = acc[ai][bj][m][0], v1 = acc[ai][bj][m][1];
                    if (act == 1) {
#pragma unroll
                        for (int e = 0; e < 4; ++e) { v0[e] = ::silu_f(v0[e]); v1[e] = ::silu_f(v1[e]); }
                    } else if (act == 2) {
#pragma unroll
                        for (int e = 0; e < 4; ++e) { v0[e] = ::gelu_f(v0[e]); v1[e] = ::gelu_f(v1[e]); }
                    }
                    v0 = v0 * sc; v1 = v1 * sc; u32x4 w; w.x = cvt_pk_bf16(v0[0], v0[1]); w.y = cvt_pk_bf16(v0[2], v0[3]); w.z = cvt_pk_bf16(v1[0], v1[1]); w.w = cvt_pk_bf16(v1[2], v1[3]);
                    *(u32x4*)(rowp + bj * HALF) = w; } }
    }
};

template <class Epi, class Sched, bool ALIGN_EPI = false, bool SP2 = false>
__device__ __forceinline__ void gemm_phase(PG8_LAS unsigned char* lds, const Gemm g, const Sched& S, const Epi& E) {
    int tid = threadIdx.x; asm volatile("" : "+v"(tid)); const int wid = __builtin_amdgcn_readfirstlane(tid >> 6), lane = tid & 63, wr = wid >> 2, wc = wid & 3, fr = lane & 15, fq = lane >> 4;
    const int K = g.K, nt = K / BK;
    unsigned voffA[2], voffB[2];
#pragma unroll
    for (int i = 0; i < 2; ++i) { int R, C; stage_rc(tid * 16 + i * 8192, R, C); const int Rb = Epi::PERM ? ((R & ~31) + perm32(R & 31)) : R;
        voffA[i] = (unsigned)(R * K + C) * 2u; voffB[i] = (unsigned)(Rb * K + C) * 2u; }
    const size_t kstep = (size_t)(BK * 2);
    const size_t hstep = (size_t)HALF * K * 2;
    const size_t tstep = 2 * hstep;
    const unsigned ldsw = (unsigned)wid * 1024u;
    const int aoff = lds_byte(wr * 64 + fr, fq * 8), boff = lds_byte(wc * 32 + fr, fq * 8);
#define PG8_SA(b, h) (((b) * 2 + (h)) * HTB)
#define PG8_SB(b, h) ((4 + (b) * 2 + (h)) * HTB)
#define PG8_STAGE(bufoff, gbase, voff) do { _Pragma("unroll") for (int _i = 0; _i < 2; ++_i) \
        __builtin_amdgcn_global_load_lds((const unsigned*)((const char*)(gbase) + (voff)[_i]), (PG8_LAS unsigned*)(lds + (bufoff) + ldsw + _i * 8192), 16, 0, 0); } while (0)
#define PG8_LDA(dst, b, h) do { _Pragma("unroll") for (int m = 0; m < 4; ++m) _Pragma("unroll") for (int k = 0; k < 2; ++k) dst[m][k] = *(const PG8_LAS bf16x8*)(lds + PG8_SA(b, h) + aoff + m * 2048 + k * 1024); } while (0)
#define PG8_LDB(dst, b, h) do { _Pragma("unroll") for (int n = 0; n < 2; ++n) _Pragma("unroll") for (int k = 0; k < 2; ++k) dst[n][k] = *(const PG8_LAS bf16x8*)(lds + PG8_SB(b, h) + boff + n * 2048 + k * 1024); } while (0)
#define PG8_MMA(ai, bj, At, Bt) do { __builtin_amdgcn_s_setprio(1); _Pragma("unroll") for (int m = 0; m < 4; ++m) _Pragma("unroll") for (int n = 0; n < 2; ++n) _Pragma("unroll") for (int k = 0; k < 2; ++k) \
        acc[ai][bj][m][n] = __builtin_amdgcn_mfma_f32_16x16x32_bf16(Bt[n][k], At[m][k], acc[ai][bj][m][n], 0, 0, 0); __builtin_amdgcn_s_setprio(0); } while (0)
#define PG8_WAIT_V(n) asm volatile("s_waitcnt vmcnt(" #n ")" ::: "memory")
#define PG8_WAIT_L(n) asm volatile("s_waitcnt lgkmcnt(" #n ")" ::: "memory")
#define PG8_BAR __builtin_amdgcn_s_barrier()
#define PG8_SCHED __builtin_amdgcn_sched_barrier(0)
    Unit cur, nxt; int ui = 0;
    if (!S.next(0, cur)) return;
    f32x4 acc[2][2][4][2];
#pragma unroll
    for (int a = 0; a < 2; ++a)
#pragma unroll
        for (int b = 0; b < 2; ++b)
#pragma unroll
            for (int m = 0; m < 4; ++m)
#pragma unroll
                for (int n = 0; n < 2; ++n) acc[a][b][m][n] = (f32x4){0.f, 0.f, 0.f, 0.f};
    bf16x8 At[4][2], B0[2][2], B1[2][2];
    const char* cA = (const char*)g.A + (size_t)cur.pm * tstep; const char* cB = (const char*)g.Bt + (size_t)cur.pn * tstep;
    S.a_ready(cur);
    if constexpr (SP2) {
        PG8_STAGE(PG8_SB(0, 0), cB, voffB); PG8_STAGE(PG8_SB(0, 1), cB + hstep, voffB); PG8_STAGE(PG8_SA(0, 0), cA, voffA); PG8_STAGE(PG8_SA(0, 1), cA + hstep, voffA);
        if (wr == 1) PG8_BAR;
        PG8_WAIT_V(2); PG8_BAR;
        PG8_STAGE(PG8_SB(1, 0), cB + kstep, voffB); PG8_STAGE(PG8_SA(1, 0), cA + kstep, voffA); PG8_STAGE(PG8_SB(1, 1), cB + hstep + kstep, voffB);
        PG8_WAIT_V(6); PG8_BAR;
    } else {
        PG8_STAGE(PG8_SB(0, 0), cB, voffB); PG8_STAGE(PG8_SA(0, 0), cA, voffA); PG8_STAGE(PG8_SB(0, 1), cB + hstep, voffB); PG8_STAGE(PG8_SA(0, 1), cA + hstep, voffA);
        if (wr == 1) PG8_BAR;
        PG8_WAIT_V(4); PG8_BAR;
        PG8_STAGE(PG8_SB(1, 0), cB + kstep, voffB); PG8_STAGE(PG8_SA(1, 0), cA + kstep, voffA); PG8_STAGE(PG8_SB(1, 1), cB + hstep + kstep, voffB);
        PG8_WAIT_V(6); PG8_BAR;
    }
    for (;;) {
        const bool has_next = S.next(ui + 1, nxt);
        const char* nA = has_next ? (const char*)g.A + (size_t)nxt.pm * tstep : cA; const char* nB = has_next ? (const char*)g.Bt + (size_t)nxt.pn * tstep : cB;
        for (int t = 0; t < nt; t += 2) {
            const bool last = (t == nt - 2);
            const char* a1 = cA + (size_t)(t + 1) * kstep;
            const char* a2 = last ? nA : cA + (size_t)(t + 2) * kstep; const char* b2 = last ? nB : cB + (size_t)(t + 2) * kstep;
            const char* a3 = a2 + kstep; const char* b3 = b2 + kstep;
            if (last && has_next) S.a_ready(nxt);
            if constexpr (SP2) {
            PG8_LDB(B0, 0, 0); PG8_LDB(B1, 0, 1); PG8_SCHED; PG8_LDA(At, 0, 0); PG8_STAGE(PG8_SA(1, 1), a1 + hstep, voffA);
            PG8_WAIT_V(8); PG8_WAIT_L(0); PG8_BAR; PG8_MMA(0, 0, At, B0); PG8_MMA(0, 1, At, B1); PG8_BAR; PG8_SCHED;
            PG8_LDA(At, 0, 1); PG8_STAGE(PG8_SB(0, 0), b2, voffB); PG8_STAGE(PG8_SB(0, 1), b2 + hstep, voffB); PG8_STAGE(PG8_SA(0, 0), a2, voffA);
            PG8_WAIT_V(8); PG8_WAIT_L(0); PG8_BAR; PG8_MMA(1, 0, At, B0); PG8_MMA(1, 1, At, B1); PG8_BAR; PG8_SCHED;
            PG8_LDB(B0, 1, 0); PG8_LDB(B1, 1, 1); PG8_SCHED; PG8_LDA(At, 1, 0); PG8_STAGE(PG8_SA(0, 1), a2 + hstep, voffA);
            PG8_WAIT_V(8); PG8_WAIT_L(0); PG8_BAR; PG8_MMA(0, 0, At, B0); PG8_MMA(0, 1, At, B1); PG8_BAR; PG8_SCHED;
            PG8_LDA(At, 1, 1); PG8_STAGE(PG8_SB(1, 0), b3, voffB); PG8_STAGE(PG8_SB(1, 1), b3 + hstep, voffB); PG8_STAGE(PG8_SA(1, 0), a3, voffA);
            PG8_WAIT_V(8); PG8_WAIT_L(0); PG8_BAR; PG8_MMA(1, 0, At, B0); PG8_MMA(1, 1, At, B1); PG8_BAR; PG8_SCHED;
            } else {
            PG8_LDB(B0, 0, 0); PG8_SCHED; PG8_LDA(At, 0, 0); PG8_STAGE(PG8_SA(1, 1), a1 + hstep, voffA);
            PG8_WAIT_L(8); PG8_BAR; PG8_WAIT_L(0); PG8_MMA(0, 0, At, B0); PG8_BAR; PG8_SCHED;
            PG8_LDB(B1, 0, 1); PG8_STAGE(PG8_SB(0, 0), b2, voffB);
            PG8_BAR; PG8_WAIT_L(0); PG8_MMA(0, 1, At, B1); PG8_BAR;
            PG8_LDA(At, 0, 1); PG8_STAGE(PG8_SA(0, 0), a2, voffA);
            PG8_BAR; PG8_WAIT_L(0); PG8_MMA(1, 0, At, B0); PG8_BAR; PG8_SCHED;
            PG8_STAGE(PG8_SB(0, 1), b2 + hstep, voffB);
            PG8_WAIT_V(6); PG8_BAR; PG8_MMA(1, 1, At, B1); PG8_BAR;
            PG8_LDB(B0, 1, 0); PG8_SCHED; PG8_LDA(At, 1, 0); PG8_STAGE(PG8_SA(0, 1), a2 + hstep, voffA);
            PG8_WAIT_L(8); PG8_BAR; PG8_WAIT_L(0); PG8_MMA(0, 0, At, B0); PG8_BAR; PG8_SCHED;
            PG8_LDB(B1, 1, 1); PG8_STAGE(PG8_SB(1, 0), b3, voffB);
            PG8_BAR; PG8_WAIT_L(0); PG8_MMA(0, 1, At, B1); PG8_BAR;
            PG8_LDA(At, 1, 1); PG8_STAGE(PG8_SA(1, 0), a3, voffA);
            PG8_BAR; PG8_WAIT_L(0); PG8_MMA(1, 0, At, B0); PG8_BAR; PG8_SCHED;
            PG8_STAGE(PG8_SB(1, 1), b3 + hstep, voffB);
            PG8_WAIT_V(6); PG8_BAR; PG8_MMA(1, 1, At, B1); PG8_BAR;
            }
        }
        if constexpr (ALIGN_EPI) { if (wr == 0) PG8_BAR; }
        if constexpr (!Epi::AFTER_DRAIN) { E(acc, cur, wr, wc, fr, fq); S.done(cur); }
        if (!has_next) break;
#pragma unroll
        for (int a = 0; a < 2; ++a)
#pragma unroll
            for (int b = 0; b < 2; ++b)
#pragma unroll
                for (int m = 0; m < 4; ++m)
#pragma unroll
                    for (int n = 0; n < 2; ++n) acc[a][b][m][n] = (f32x4){0.f, 0.f, 0.f, 0.f};
        cur = nxt; cA = nA; cB = nB; ++ui;
        if constexpr (ALIGN_EPI) { if (wr == 1) PG8_BAR; }
    }
    PG8_WAIT_V(0);
    if constexpr (!ALIGN_EPI) { if (wr == 0) PG8_BAR; }
    PG8_BAR;
    if constexpr (Epi::AFTER_DRAIN) { E.fused(acc, cur, wr, wc, fr, fq, lds, wid, lane); S.done(cur); }
#undef PG8_SA
#undef PG8_SB
#undef PG8_STAGE
#undef PG8_LDA
#undef PG8_LDB
#undef PG8_MMA
#undef PG8_WAIT_V
#undef PG8_WAIT_L
#undef PG8_BAR
#undef PG8_SCHED
}
}

#include <hip/hip_bf16.h>
#include <cmath>
namespace attn_body {
using bf16=__hip_bfloat16;
using bf16x8=__attribute__((ext_vector_type(8)))short;
using s16x4=__attribute__((ext_vector_type(4)))short;
using f32x16=__attribute__((ext_vector_type(16)))float;
using u32x4=__attribute__((ext_vector_type(4)))unsigned;
using f32x4=__attribute__((ext_vector_type(4)))float;
constexpr int BATCH=4,NHEAD=8,SEQ=4096,D=64,DM=NHEAD*D,ODM=1024;
constexpr int NW=8,QBLK=32,QB=QBLK*NW,KVBLK=64,NQB=SEQ/QB;
constexpr int ATTN_PITCH=DM, ATTN_UNIT_ROWS=QB;
__device__ __forceinline__ int crow(int r,int hi){return (r&3)+8*(r>>2)+4*hi;}
#define SBAR() __builtin_amdgcn_sched_barrier(0)
__device__ __forceinline__ void cmask(f32x16&p0,f32x16&p1,int jb,int qrel,int hi){
  const float NEG=-INFINITY; int kb=64*jb+4*hi;
  #pragma unroll
  for(int r=0;r<16;++r){int kv=kb+(r&3)+8*(r>>2); if(kv>qrel)p0[r]=NEG; if(kv+32>qrel)p1[r]=NEG;}
}

constexpr int NSLOT=3, SLOTB=8192;
constexpr int LDS_K=0, LDS_V=NSLOT*SLOTB, LDS_WS=2*NSLOT*SLOTB, LDS_OST=LDS_WS+NW*64*4, LDS_FK=LDS_OST+NW*4096, LDS_BYTES=LDS_FK+SEQ*4+4096;
constexpr float C2=0.125f*1.4426950408889634f;
__device__ __forceinline__ void glds16(const void*gsrc,unsigned lds_dst){unsigned keep;
  asm volatile("s_mov_b32 %0, m0\n\ts_mov_b32 m0, %2\n\ts_nop 0\n\tglobal_load_lds_dwordx4 %1, off\n\ts_mov_b32 m0, %0":"=&s"(keep):"v"(gsrc),"s"(lds_dst):"memory");}
__device__ __forceinline__ float max3f(float a,float b,float c){float r;asm("v_max3_f32 %0, %1, %2, %3":"=v"(r):"v"(a),"v"(b),"v"(c));return r;}
__device__ __forceinline__ float max2f(float a,float b){float r;asm("v_max_f32_e32 %0, %1, %2":"=v"(r):"v"(a),"v"(b));return r;}
__device__ __forceinline__ float fadd_s(float a,float b){float r;asm("v_add_f32_e32 %0, %1, %2":"=v"(r):"v"(a),"v"(b));return r;}
__device__ __forceinline__ float fsub_s(float a,float b){float r;asm("v_sub_f32_e32 %0, %1, %2":"=v"(r):"v"(a),"v"(b));return r;}
typedef float f32x2_t __attribute__((ext_vector_type(2))); typedef __bf16 bf16x2_t __attribute__((ext_vector_type(2)));
__device__ __forceinline__ unsigned cvtpk_s(float lo,float hi){f32x2_t v={lo,hi};bf16x2_t b=__builtin_convertvector(v,bf16x2_t);return __builtin_bit_cast(unsigned,b);}
#define WAIT_BAR(N) asm volatile("s_waitcnt vmcnt(" #N ") lgkmcnt(0)\n\ts_barrier":::"memory")

__device__ __forceinline__ void qkt(f32x16&p0,f32x16&p1,const char*Kslot,const bf16x8*qr,int r32,int hi){
  const char*kb=Kslot+hi*1024+r32*16;
  #pragma unroll
  for(int d0=0;d0<4;++d0){
    const bf16x8 b0=*reinterpret_cast<const bf16x8*>(kb+d0*2048);
    const bf16x8 b1=*reinterpret_cast<const bf16x8*>(kb+d0*2048+512);
    p0=__builtin_amdgcn_mfma_f32_32x32x16_bf16(b0,qr[d0],p0,0,0,0);p1=__builtin_amdgcn_mfma_f32_32x32x16_bf16(b1,qr[d0],p1,0,0,0);}
}
typedef __attribute__((address_space(3))) const char* lds_cptr;
typedef short v4i16_t __attribute__((ext_vector_type(4)));
__device__ __forceinline__ void kload8(bf16x8*kf,lds_cptr kp){
  kf[0]=*(const __attribute__((address_space(3))) bf16x8*)(kp);      kf[1]=*(const __attribute__((address_space(3))) bf16x8*)(kp+512);
  kf[2]=*(const __attribute__((address_space(3))) bf16x8*)(kp+2048); kf[3]=*(const __attribute__((address_space(3))) bf16x8*)(kp+2560);
  kf[4]=*(const __attribute__((address_space(3))) bf16x8*)(kp+4096); kf[5]=*(const __attribute__((address_space(3))) bf16x8*)(kp+4608);
  kf[6]=*(const __attribute__((address_space(3))) bf16x8*)(kp+6144); kf[7]=*(const __attribute__((address_space(3))) bf16x8*)(kp+6656);
}
__device__ __forceinline__ void kload2(bf16x8*kf,lds_cptr kp,int j){ kf[2*j]=*(const __attribute__((address_space(3))) bf16x8*)(kp+j*2048); kf[2*j+1]=*(const __attribute__((address_space(3))) bf16x8*)(kp+j*2048+512); }
__device__ __forceinline__ s16x4 vtr(lds_cptr p){ return __builtin_bit_cast(s16x4,__builtin_amdgcn_ds_read_tr16_b64_v4i16((__attribute__((address_space(3))) v4i16_t*)p)); }
__device__ __forceinline__ float rowmax(const f32x16&p0,const f32x16&p1){
  float a=max3f(p0[0],p0[1],p1[0]),b=max3f(p0[2],p0[3],p1[1]);a=max3f(a,p1[2],p1[3]);
  #pragma unroll
  for(int r=4;r<16;r+=4){a=max3f(a,p0[r],p0[r+1]);b=max3f(b,p0[r+2],p0[r+3]);a=max3f(a,p1[r],p1[r+1]);b=max3f(b,p1[r+2],p1[r+3]);}
  const float m=max2f(a,b);
  auto rr=__builtin_amdgcn_permlane32_swap(__float_as_uint(m),__float_as_uint(m),false,false);
  return max2f(__uint_as_float(rr[0]),__uint_as_float(rr[1]));
}
__device__ __forceinline__ void pv(f32x16*o,int vb,bf16x8 pa0,bf16x8 pa1,bf16x8 pa2,bf16x8 pa3){
  #pragma unroll
  for(int d0=0;d0<2;++d0){s16x4 lo[4],hi[4];
    #pragma unroll
    for(int ks=0;ks<4;++ks){
      asm volatile("ds_read_b64_tr_b16 %0,%1 offset:%c2":"=&v"(lo[ks]):"v"(vb),"i"(d0*4096+ks*1024):"memory");
      asm volatile("ds_read_b64_tr_b16 %0,%1 offset:%c2":"=&v"(hi[ks]):"v"(vb),"i"(d0*4096+ks*1024+512):"memory");}
    asm volatile("s_waitcnt lgkmcnt(0)":::"memory");SBAR();
    #define PK(k) (bf16x8){lo[k][0],lo[k][1],lo[k][2],lo[k][3],hi[k][0],hi[k][1],hi[k][2],hi[k][3]}
    o[d0]=__builtin_amdgcn_mfma_f32_32x32x16_bf16(pa0,PK(0),o[d0],0,0,0);
    o[d0]=__builtin_amdgcn_mfma_f32_32x32x16_bf16(pa1,PK(1),o[d0],0,0,0);
    o[d0]=__builtin_amdgcn_mfma_f32_32x32x16_bf16(pa2,PK(2),o[d0],0,0,0);
    o[d0]=__builtin_amdgcn_mfma_f32_32x32x16_bf16(pa3,PK(3),o[d0],0,0,0);
    #undef PK
  }
}

#ifndef ATTN_STORE16
#define ATTN_STORE16(p,v) (*(u32x4*)(p)=(v))
#endif
template<int THRL,bool STAGE_FK> __device__ __forceinline__ void attn_unit(int b,int h,int qb,const bf16*Q,const bf16*__restrict__ K,const bf16*__restrict__ V,bf16*O,const bf16*__restrict__ Gt,const float*__restrict__ Fc,char*shm){
  int tid=threadIdx.x; asm volatile("":"+v"(tid)); const int lane=tid&63,r32=lane&31,hi=lane>>5; const int wid=__builtin_amdgcn_readfirstlane(tid>>6);
  const long rowbase=(long)b*SEQ; const int q0=qb*QB;
  const bf16*Qw=Q+(rowbase+q0+wid*QBLK)*DM+h*D;
  const bf16*Kh=K+rowbase*DM+h*D,*Vh=V+rowbase*DM+h*D;
  const unsigned lds0=(unsigned)(uintptr_t)shm;
  float*wsf=(float*)(shm+LDS_WS)+wid*64;
  const bf16*ksrc=Kh+(long)lane*DM+wid*8;
  const bf16*vsrc=Vh+(long)(16*(wid&3)+(lane>>2))*DM+(wid>>2)*32+(lane&3)*8;
  const unsigned kdst=lds0+LDS_K+wid*1024, vdst=lds0+LDS_V+wid*1024;
  #define DMA_K(t,slot) glds16(ksrc+(long)(t)*KVBLK*DM,(unsigned)__builtin_amdgcn_readfirstlane(kdst+(slot)))
  #define DMA_V(t,slot) glds16(vsrc+(long)(t)*KVBLK*DM,(unsigned)__builtin_amdgcn_readfirstlane(vdst+(slot)))
  const int vb0=(int)(lds0+LDS_V)+((lane>>4)&1)*32+(lane&3)*8+(4*hi+((lane&15)>>2))*64;
  const char*Kbase=shm+LDS_K; bf16x8 kf[8];
  const lds_cptr shm3=(lds_cptr)shm; const lds_cptr kp0=shm3+LDS_K+hi*1024+r32*16; const lds_cptr vp0=shm3+LDS_V+((lane>>4)&1)*32+(lane&3)*8+(4*hi+((lane&15)>>2))*64;
  const int NT=(q0+QB)/KVBLK;
  float fqm;
  if(STAGE_FK){ f32x4*fkw=(f32x4*)(shm+LDS_FK); const int n4=(q0+QB)>>2; for(int i=tid;i<n4;i+=NW*64)fkw[i]=((const f32x4*)Fc)[i];
    fqm=Fc[q0+wid*QBLK+r32]; asm volatile("s_waitcnt vmcnt(0) lgkmcnt(0)\n\ts_barrier":::"memory"); }
  else fqm=((const float*)(shm+LDS_FK))[q0+wid*QBLK+r32];
  typedef __attribute__((address_space(3))) const f32x4* lds_f4ptr;
  const lds_cptr fk0=(lds_cptr)shm+LDS_FK+hi*16;
  #define CINIT(C0,C1,t) do{ const lds_cptr fp_=fk0+(t)*256; \
    _Pragma("unroll") for(int g_=0;g_<4;++g_){ const f32x4 a_=*(lds_f4ptr)(fp_+g_*32); const f32x4 b_=*(lds_f4ptr)(fp_+128+g_*32); \
      _Pragma("unroll") for(int e_=0;e_<4;++e_){ C0[g_*4+e_]=fqm-a_[e_]; C1[g_*4+e_]=fqm-b_[e_]; } } }while(0)
  DMA_K(0,0);DMA_V(0,0);DMA_K(1,SLOTB);
  bf16x8 qr[4];
  #pragma unroll
  for(int d0=0;d0<4;++d0)qr[d0]=*reinterpret_cast<const bf16x8*>(&Qw[(long)r32*DM+d0*16+hi*8]);
  float l_reg=0.f;f32x16 o[2];o[0]=f32x16{};o[1]=f32x16{};
  const int qrel=wid*QBLK+r32;
  #define CMASK(P0,P1,t) do{int jb_=(t)-(NT-4); if(jb_>=0)cmask(P0,P1,jb_,qrel,hi);}while(0)
  bool resc=false;
  #define START(P0,P1) do{ const float rm=rowmax(P0,P1); resc=false; \
    { const float dl=rm; fqm=fsub_s(fqm,dl); \
      _Pragma("unroll") for(int r=0;r<16;++r){P0[r]=fsub_s(P0[r],dl);P1[r]=fsub_s(P1[r],dl);} } \
    _Pragma("unroll") for(int r=0;r<16;++r)P0[r]=__builtin_amdgcn_exp2f(P0[r]); }while(0)
  #define RESC() do{ if(resc){ asm volatile("s_waitcnt lgkmcnt(0)":::"memory"); \
      _Pragma("unroll") for(int d_=0;d_<2;++d_) _Pragma("unroll") for(int r=0;r<16;++r)o[d_][r]*=wsf[crow(r,hi)]; } }while(0)
  f32x16 pA0,pA1,pB0,pB1;
  int sl_prev=0,sl_cur=0,sl_next=SLOTB;
  #define ROT() do{sl_prev=sl_cur;sl_cur=sl_next;sl_next=(sl_next==(NSLOT-1)*SLOTB)?0:sl_next+SLOTB;}while(0)
  DMA_K(2,2*SLOTB);
  WAIT_BAR(3);
  CINIT(pA0,pA1,0); qkt(pA0,pA1,Kbase,qr,r32,hi);asm volatile("s_nop 15\n\ts_nop 7":"+v"(pA0),"+v"(pA1));CMASK(pA0,pA1,0);
  START(pA0,pA1);
  _Pragma("unroll") for(int r=0;r<16;++r)pA1[r]=__builtin_amdgcn_exp2f(pA1[r]);
  WAIT_BAR(0);
  DMA_K(3,0);DMA_V(1,SLOTB);
  ROT();
  kload8(kf,kp0+sl_cur);
  WAIT_BAR(2);
  s16x4 vlo[8],vhi[8]; u32x4 pw0,pw1,pw2,pw3;
  #define PKW(P,B) cvtpk_s(P[B],P[B+1])
  #define PAF(k) __builtin_bit_cast(bf16x8,pw##k)
  #define VFR(i) (bf16x8){vlo[i][0],vlo[i][1],vlo[i][2],vlo[i][3],vhi[i][0],vhi[i][1],vhi[i][2],vhi[i][3]}
  #define PIN(x) asm volatile("":"+v"(x))
  #define MX3(a,b,c) __builtin_fmaxf(__builtin_fmaxf((a),(b)),(c))
  #define GAPA(MF,A0,A1,A2,A3,W0,W1,PW) do{ MF; sacc+=A0; sacc+=A1; sacc+=A2; sacc+=A3; PIN(sacc); W0; W1; PIN(PW); SBAR(); }while(0)
  #define EX(v) __builtin_amdgcn_exp2f(v)
  #define GAPB(MF,X,B) do{ MF; X[B]=EX(X[B]); X[B+1]=EX(X[B+1]); X[B+2]=EX(X[B+2]); X[B+3]=EX(X[B+3]); PIN(X); SBAR(); }while(0)
  #define VRD(i) do{ vlo[i]=vtr(vp_+(((i)>>2)*4096+((i)&3)*1024)); vhi[i]=vtr(vp_+(((i)>>2)*4096+((i)&3)*1024+512)); }while(0)
  #define KRD(G,j) do{ if(G){ kload2(kf,kp0+sl_next,j); SBAR(); } }while(0)
  #define STEP(C0,C1,P0,P1,t,GK,GV,GL) do{ SBAR(); CINIT(C0,C1,t); SBAR(); \
    const lds_cptr vp_=vp0+sl_prev; \
    VRD(0); SBAR(); float sacc=(P0[0]+P0[1]); \
    GAPA(C0=__builtin_amdgcn_mfma_f32_32x32x16_bf16(kf[0],qr[0],C0,0,0,0), P0[2],P0[3],P0[4],P0[5],     pw0[0]=PKW(P0,0), pw0[1]=PKW(P0,2), pw0); \
    VRD(4); SBAR(); GAPA(C1=__builtin_amdgcn_mfma_f32_32x32x16_bf16(kf[1],qr[0],C1,0,0,0), P0[6],P0[7],P0[8],P0[9],     pw0[2]=PKW(P0,4), pw0[3]=PKW(P0,6), pw0); \
    VRD(1); SBAR(); GAPA(C0=__builtin_amdgcn_mfma_f32_32x32x16_bf16(kf[2],qr[1],C0,0,0,0),   P0[10],P0[11],P0[12],P0[13], pw1[0]=PKW(P0,8), pw1[1]=PKW(P0,10), pw1); \
    VRD(5); SBAR(); GAPA(C1=__builtin_amdgcn_mfma_f32_32x32x16_bf16(kf[3],qr[1],C1,0,0,0),   P0[14],P0[15],P1[0],P1[1],   pw1[2]=PKW(P0,12),pw1[3]=PKW(P0,14), pw1); \
    VRD(2); SBAR(); GAPA(C0=__builtin_amdgcn_mfma_f32_32x32x16_bf16(kf[4],qr[2],C0,0,0,0),   P1[2],P1[3],P1[4],P1[5],     pw2[0]=PKW(P1,0), pw2[1]=PKW(P1,2), pw2); \
    VRD(6); SBAR(); GAPA(C1=__builtin_amdgcn_mfma_f32_32x32x16_bf16(kf[5],qr[2],C1,0,0,0),   P1[6],P1[7],P1[8],P1[9],     pw2[2]=PKW(P1,4), pw2[3]=PKW(P1,6), pw2); \
    VRD(3); SBAR(); GAPA(C0=__builtin_amdgcn_mfma_f32_32x32x16_bf16(kf[6],qr[3],C0,0,0,0),   P1[10],P1[11],P1[12],P1[13], pw3[0]=PKW(P1,8), pw3[1]=PKW(P1,10), pw3); \
    VRD(7); SBAR(); GAPA(C1=__builtin_amdgcn_mfma_f32_32x32x16_bf16(kf[7],qr[3],C1,0,0,0),   P1[14],P1[15],0.f,0.f,       pw3[2]=PKW(P1,12),pw3[3]=PKW(P1,14), pw3); \
    l_reg+=sacc; \
    if(GK){DMA_K((t)+3,sl_cur);} if(GV){DMA_V((t)+1,sl_next);} \
    CMASK(C0,C1,t); \
    { float a=MX3(C0[0],C0[1],C1[0]),b=MX3(C0[2],C0[3],C1[1]); a=MX3(a,C1[2],C1[3]); \
      _Pragma("unroll") for(int r=4;r<16;r+=4){a=MX3(a,C0[r],C0[r+1]);b=MX3(b,C0[r+2],C0[r+3]);a=MX3(a,C1[r],C1[r+1]);b=MX3(b,C1[r+2],C1[r+3]);} \
      float rm=__builtin_fmaxf(a,b); { auto rr=__builtin_amdgcn_permlane32_swap(__float_as_uint(rm),__float_as_uint(rm),false,false); rm=__builtin_fmaxf(__uint_as_float(rr[0]),__uint_as_float(rr[1])); } \
      resc=false; \
      if(__builtin_expect(__any(rm>(float)THRL),0)){ const float dl=__builtin_fmaxf(rm,0.f); fqm-=dl; \
        _Pragma("unroll") for(int r=0;r<16;++r){C0[r]-=dl;C1[r]-=dl;} \
        const float f=__builtin_amdgcn_exp2f(-dl); l_reg*=f; if(hi==0)wsf[r32]=f; resc=true; } } \
    SBAR(); \
    GAPB(o[0]=__builtin_amdgcn_mfma_f32_32x32x16_bf16(PAF(0),VFR(0),o[0],0,0,0), C0,0); \
    GAPB(o[1]=__builtin_amdgcn_mfma_f32_32x32x16_bf16(PAF(0),VFR(4),o[1],0,0,0), C0,4); \
    KRD(GL,0); GAPB(o[0]=__builtin_amdgcn_mfma_f32_32x32x16_bf16(PAF(1),VFR(1),o[0],0,0,0), C0,8); \
    KRD(GL,1); GAPB(o[1]=__builtin_amdgcn_mfma_f32_32x32x16_bf16(PAF(1),VFR(5),o[1],0,0,0), C0,12); \
    KRD(GL,2); GAPB(o[0]=__builtin_amdgcn_mfma_f32_32x32x16_bf16(PAF(2),VFR(2),o[0],0,0,0), C1,0); \
    KRD(GL,3); GAPB(o[1]=__builtin_amdgcn_mfma_f32_32x32x16_bf16(PAF(2),VFR(6),o[1],0,0,0), C1,4); \
    GAPB(o[0]=__builtin_amdgcn_mfma_f32_32x32x16_bf16(PAF(3),VFR(3),o[0],0,0,0), C1,8); \
    GAPB(o[1]=__builtin_amdgcn_mfma_f32_32x32x16_bf16(PAF(3),VFR(7),o[1],0,0,0), C1,12); \
    }while(0)
  int t=1;
  #undef CMASK
  #define CMASK(P0,P1,t) do{}while(0)
  for(;t+5<NT;t+=2){
    STEP(pB0,pB1,pA0,pA1,t,true,true,true);     WAIT_BAR(2); RESC(); ROT();
    STEP(pA0,pA1,pB0,pB1,t+1,true,true,true);   WAIT_BAR(2); RESC(); ROT();
  }
  #undef CMASK
  #define CMASK(P0,P1,t) do{int jb_=(t)-(NT-4); if(jb_>=0)cmask(P0,P1,jb_,qrel,hi);}while(0)
  #define ENDW(tt) do{ if((tt)+3<NT){WAIT_BAR(2);} else if((tt)+2<NT){WAIT_BAR(1);} else {WAIT_BAR(0);} }while(0)
  for(;t+1<NT;t+=2){
    STEP(pB0,pB1,pA0,pA1,t,(t+3<NT),(t+1<NT),(t+1<NT));       ENDW(t);   RESC(); ROT();
    STEP(pA0,pA1,pB0,pB1,t+1,(t+4<NT),(t+2<NT),(t+2<NT));     ENDW(t+1); RESC(); ROT();
  }
  STEP(pB0,pB1,pA0,pA1,NT-1,false,false,false); RESC();
  { float sacc=pB0[0]+pB0[1]; _Pragma("unroll") for(int r=2;r<16;++r)sacc+=pB0[r]; _Pragma("unroll") for(int r=0;r<16;++r)sacc+=pB1[r]; l_reg+=sacc;
    pw0=(u32x4){PKW(pB0,0),PKW(pB0,2),PKW(pB0,4),PKW(pB0,6)};pw1=(u32x4){PKW(pB0,8),PKW(pB0,10),PKW(pB0,12),PKW(pB0,14)};pw2=(u32x4){PKW(pB1,0),PKW(pB1,2),PKW(pB1,4),PKW(pB1,6)};pw3=(u32x4){PKW(pB1,8),PKW(pB1,10),PKW(pB1,12),PKW(pB1,14)};
    SBAR(); pv(o,vb0+sl_cur,PAF(0),PAF(1),PAF(2),PAF(3)); }
  #undef PKW
  #undef PAF
  #undef VFR
  #undef PIN
  #undef MX3
  #undef GAPA
  #undef GAPB
  #undef EX
  #undef VRD
  #undef KRD
  #undef STEP
  #undef ENDW
  {auto rr=__builtin_amdgcn_permlane32_swap(__float_as_uint(l_reg),__float_as_uint(l_reg),false,false);l_reg=__uint_as_float(rr[0])+__uint_as_float(rr[1]);}
  if(hi==0)wsf[32+r32]=l_reg;asm volatile("s_waitcnt lgkmcnt(0)":::"memory");
  float rli[16];
  #pragma unroll
  for(int r=0;r<16;++r)rli[r]=__builtin_amdgcn_rcpf(wsf[32+crow(r,hi)]);
  bf16*Ow=O+(rowbase+q0+wid*QBLK)*ODM+h*D; const bf16*Gw=Gt+(rowbase+q0+wid*QBLK)*DM+h*D;
  { bf16*stg=(bf16*)(shm+LDS_OST)+wid*2048;
    #pragma unroll
    for(int r=0;r<16;++r){const int orow=crow(r,hi);
      #pragma unroll
      for(int d0=0;d0<2;++d0)stg[orow*64+d0*32+r32]=__float2bfloat16(o[d0][r]*rli[r]);}
    asm volatile("s_waitcnt lgkmcnt(0)":::"memory");
    #pragma unroll
    for(int i=0;i<4;++i){const int row=i*8+(lane>>3),ch=lane&7; u32x4 v=*(const u32x4*)(stg+row*64+ch*8); const u32x4 g=*(const u32x4*)(Gw+(long)row*DM+ch*8);
      #pragma unroll
      for(int e=0;e<4;++e)v[e]=cvtpk_s(__uint_as_float(v[e]<<16)*__uint_as_float(g[e]<<16),__uint_as_float(v[e]&0xffff0000u)*__uint_as_float(g[e]&0xffff0000u));
      ATTN_STORE16(Ow+(long)row*ODM+ch*8,v);} }
  asm volatile("s_waitcnt lgkmcnt(0)\n\ts_barrier":::"memory");
  #undef CINIT
  #undef DMA_K
  #undef DMA_V
  #undef CMASK
  #undef START
  #undef RESC
  #undef ROT
}
constexpr int ATTN_LDS_BYTES=LDS_BYTES;
#undef SBAR
#undef WAIT_BAR
}

__device__ __forceinline__ void p0_mod_item(int item, const Params& p, float* MOD, float* lds) {
    int tid = threadIdx.x; asm volatile("" : "+v"(tid));
    const int l = item / 48, n0 = (item % 48) * 64;
    float* sc = lds;
    float* red = lds + 4096;
    for (int i = tid; i < 4096; i += NTHREADS) sc[i] = silu_f(p.c[i]);
    __syncthreads();
    const int nl = tid & 63, ks = tid >> 6;
    float a0 = 0.f, a1 = 0.f, a2 = 0.f, a3 = 0.f;
    const float* w = p.ada_w + ((size_t)l * 1024 + ks * 128) * 3072 + n0 + nl;
#pragma unroll 8
    for (int k = 0; k < 128; ++k) {
        const float wv = w[(size_t)k * 3072]; const int kk = ks * 128 + k;
        a0 += sc[kk] * wv; a1 += sc[1024 + kk] * wv; a2 += sc[2048 + kk] * wv; a3 += sc[3072 + kk] * wv;
    }
    red[(ks * 4 + 0) * 64 + nl] = a0; red[(ks * 4 + 1) * 64 + nl] = a1; red[(ks * 4 + 2) * 64 + nl] = a2; red[(ks * 4 + 3) * 64 + nl] = a3;
    __syncthreads();
    if (tid < 256) {
        const int b = tid >> 6; float s = p.ada_b[l * 3072 + n0 + nl];
#pragma unroll
        for (int k = 0; k < 8; ++k) s += red[(k * 4 + b) * 64 + nl];
        MOD[(size_t)(l * 4 + b) * 3072 + n0 + nl] = s;
    }
    __syncthreads();
}
__device__ __forceinline__ void p0_tr_item(const float* W, int ldn, int k0, int csrc0, bf16_t* WT, int n0, float* tile) {
    int tid = threadIdx.x; asm volatile("" : "+v"(tid));
    {
        const int r = tid >> 6, cc = tid & 63;
#pragma unroll
        for (int i = 0; i < 8; ++i) { const int k = r + 8 * i; tile[k * 65 + cc] = W[(size_t)(k0 + k) * ldn + csrc0 + cc]; }
    }
    __syncthreads();
    {
        const int n = tid >> 3, kc = tid & 7;
        const float* s = tile + (kc * 8) * 65 + n;
        uint4 o; o.x = pk2(s[0], s[65]); o.y = pk2(s[2 * 65], s[3 * 65]); o.z = pk2(s[4 * 65], s[5 * 65]); o.w = pk2(s[6 * 65], s[7 * 65]);
        *(uint4*)(WT + (size_t)(n0 + n) * 1024 + k0 + kc * 8) = o;
    }
    __syncthreads();
}
__device__ __forceinline__ void p0_prologue(const Params& p, float* lds) {
    unsigned char* ws = p.ws;
    float* MOD = (float*)(ws + WS_MOD);
    const int G = gridDim.x, blk = blockIdx.x; int tid = threadIdx.x; asm volatile("" : "+v"(tid));
    constexpr int N_MOD = 96, N_WIN = 2 * 16 * 52, N_WOUT = 2 * 16 * 16;
    for (int it = blk; it < N_MOD + N_WIN + N_WOUT; it += G) {
        if (it < N_MOD) { p0_mod_item(it, p, MOD, lds); continue; }
        int r = it - N_MOD;
        if (r < N_WIN) {
            const int l = r / (16 * 52), q = r % (16 * 52), kb = q / 52, nb = q % 52;
            const int n0 = nb * 64, csrc0 = n0 + (n0 >= FCOL ? 8 : 0);
            p0_tr_item(p.w_in + (size_t)l * 1024 * DIN, DIN, kb * 64, csrc0, (bf16_t*)(ws + WS_WINT + l * WS_WINT_STRIDE), n0, lds);
            continue;
        }
        r -= N_WIN;
        { const int l = r / 256, q = r % 256, kb = q / 16, nb = q % 16;
          p0_tr_item(p.w_out + (size_t)l * 1024 * 1024, 1024, kb * 64, nb * 64, (bf16_t*)(ws + WS_WOUTT + (size_t)l * 2 * MiB), nb * 64, lds); }
    }
    const int gt = blk * NTHREADS + tid, GT = G * NTHREADS;
    for (int i = gt; i < 2 * 256 * 128; i += GT) {
        const int kc = i & 127, r = (i >> 7) & 255, l = i >> 15;
        uint4 o = make_uint4(0u, 0u, 0u, 0u);
        if (r < 8) { const float* src = p.w_in + ((size_t)l * 1024 + kc * 8) * DIN + FCOL + r;
            o.x = pk2(src[0], src[DIN]); o.y = pk2(src[2 * DIN], src[3 * DIN]); o.z = pk2(src[4 * DIN], src[5 * DIN]); o.w = pk2(src[6 * DIN], src[7 * DIN]); }
        *(uint4*)((bf16_t*)(ws + WS_WINT + l * WS_WINT_STRIDE) + (size_t)(NPROJ + r) * 1024 + kc * 8) = o;
    }
    bf16_t* SGW = (bf16_t*)(ws + WS_SGW);
    for (int i = gt; i < 2 * 4 * 128 * 128; i += GT) { const int s = i & 127, t = (i >> 7) & 127; SGW[i] = (bf16_t)(s <= t ? f2bf(p.sg_w[i]) : 0u); }
    bf16_t* WAT = (bf16_t*)(ws + WS_WAT);
    for (int i = gt; i < 2 * 2 * 4 * 64 * 64; i += GT) {
        const int ii = i & 63, j = (i >> 6) & 63, g = (i >> 12) & 3, mat = (i >> 14) & 1, l = i >> 15;
        const float* src = mat ? p.lru_wx : p.lru_wa;
        WAT[i] = (bf16_t)f2bf(src[((size_t)(l * 4 + g) * 64 + ii) * 64 + j]);
    }
}

template <bool FIRST, bool NEXT>
__device__ __forceinline__ void row_pass(const Params& p, int lprev, int ln, const float* xres, float* xout, float* lds) {
    unsigned char* ws = p.ws;
    int tid = threadIdx.x; asm volatile("" : "+v"(tid)); const int lane = tid & 63, wave = tid >> 6;
    const float* MOD = (const float*)(ws + WS_MOD);
    const bf16_t* YOUT = (const bf16_t*)(ws + WS_YOUT);
    bf16_t* H = (bf16_t*)(ws + WS_H);
    const int gw = blockIdx.x * 8 + wave, NGW = gridDim.x * 8;
    for (int row = gw; row < MROWS; row += NGW) {
        const int b = row >> 12;
        f32x4 xv[4];
#pragma unroll
        for (int j = 0; j < 4; ++j) xv[j] = *(const f32x4*)(xres + (size_t)row * DM + j * 256 + lane * 4);
        if (!FIRST) {
            f32x4 yv[4]; float ss = 0.f;
#pragma unroll
            for (int j = 0; j < 4; ++j) {
                const uint2 w = *(const uint2*)(YOUT + (size_t)row * DM + j * 256 + lane * 4);
                yv[j] = (f32x4){bflo(w.x), bfhi(w.x), bflo(w.y), bfhi(w.y)};
                ss += (yv[j].x * yv[j].x + yv[j].y * yv[j].y) + (yv[j].z * yv[j].z + yv[j].w * yv[j].w);
            }
            const float rinv = rsqrtf(wave_sum(ss) * (1.f / DM) + EPS);
            const float* gate = MOD + (size_t)(lprev * 4 + b) * 3072 + 2048;
#pragma unroll
            for (int j = 0; j < 4; ++j) {
                const f32x4 pg = *(const f32x4*)(p.post_g + lprev * DM + j * 256 + lane * 4);
                const f32x4 gt = *(const f32x4*)(gate + j * 256 + lane * 4);
                xv[j] = xv[j] + gt * ((yv[j] * rinv) * pg);
                *(f32x4*)(xout + (size_t)row * DM + j * 256 + lane * 4) = xv[j];
            }
        }
        if (NEXT) {
            float ss = 0.f;
#pragma unroll
            for (int j = 0; j < 4; ++j) ss += (xv[j].x * xv[j].x + xv[j].y * xv[j].y) + (xv[j].z * xv[j].z + xv[j].w * xv[j].w);
            const float rinv = rsqrtf(wave_sum(ss) * (1.f / DM) + EPS);
            const float* shift = MOD + (size_t)(ln * 4 + b) * 3072;
            const float* scale = shift + 1024;
#pragma unroll
            for (int j = 0; j < 4; ++j) {
                const int c0 = j * 256 + lane * 4;
                const f32x4 pg = *(const f32x4*)(p.pre_g + ln * DM + c0);
                const f32x4 sh = *(const f32x4*)(shift + c0);
                const f32x4 sc = *(const f32x4*)(scale + c0);
                const f32x4 hv = ((xv[j] * rinv) * pg) * (sc + 1.0f) + sh;
                uint2 o; o.x = pk2(hv.x, hv.y); o.y = pk2(hv.z, hv.w);
                *(uint2*)(H + (size_t)row * DM + c0) = o;
            }
        }
    }
    __syncthreads();
}

template <class Store>
__device__ __forceinline__ void gemm_naive(const bf16_t* A, const bf16_t* Bt, int N, float* lds, const Store& st) {
    float* As = lds; float* Bs = lds + 32 * 68;
    int tid = threadIdx.x; asm volatile("" : "+v"(tid)); const int ntn = N / 64, ntiles = (MROWS / 64) * ntn;
    const int r = tid >> 3, kq = tid & 7, ty = tid >> 4, tx = tid & 15;
    for (int tile = blockIdx.x; tile < ntiles; tile += gridDim.x) {
        const int tm = tile / ntn, tn = tile % ntn;
        float acc[2][4];
#pragma unroll
        for (int i = 0; i < 2; ++i)
#pragma unroll
            for (int j = 0; j < 4; ++j) acc[i][j] = 0.f;
        for (int k0 = 0; k0 < 1024; k0 += 32) {
            const uint2 av = *(const uint2*)(A + (size_t)(tm * 64 + r) * 1024 + k0 + kq * 4);
            const uint2 bv = *(const uint2*)(Bt + (size_t)(tn * 64 + r) * 1024 + k0 + kq * 4);
            As[(kq * 4 + 0) * 68 + r] = bflo(av.x); As[(kq * 4 + 1) * 68 + r] = bfhi(av.x); As[(kq * 4 + 2) * 68 + r] = bflo(av.y); As[(kq * 4 + 3) * 68 + r] = bfhi(av.y);
            Bs[(kq * 4 + 0) * 68 + r] = bflo(bv.x); Bs[(kq * 4 + 1) * 68 + r] = bfhi(bv.x); Bs[(kq * 4 + 2) * 68 + r] = bflo(bv.y); Bs[(kq * 4 + 3) * 68 + r] = bfhi(bv.y);
            __syncthreads();
#pragma unroll 8
            for (int k = 0; k < 32; ++k) {
                const float2 a = *(const float2*)&As[k * 68 + ty * 2];
                const float4 bq = *(const float4*)&Bs[k * 68 + tx * 4];
                acc[0][0] += a.x * bq.x; acc[0][1] += a.x * bq.y; acc[0][2] += a.x * bq.z; acc[0][3] += a.x * bq.w;
                acc[1][0] += a.y * bq.x; acc[1][1] += a.y * bq.y; acc[1][2] += a.y * bq.z; acc[1][3] += a.y * bq.w;
            }
            __syncthreads();
        }
#pragma unroll
        for (int i = 0; i < 2; ++i)
#pragma unroll
            for (int j = 0; j < 4; ++j) st(tm * 64 + ty * 2 + i, tn * 64 + tx * 4 + j, acc[i][j]);
    }
}
struct StoreProj { ProjOut P; __device__ __forceinline__ void operator()(int row, int n, float v) const { proj_store(P, row, n, v); } };
struct StoreBf16 { bf16_t* O; int ld; __device__ __forceinline__ void operator()(int row, int n, float v) const { O[(size_t)row * ld + n] = (bf16_t)f2bf(v); } };

__device__ __forceinline__ void fk_cumsum(const float* LSbh, int n, unsigned char* shm) {
    int tid = threadIdx.x; asm volatile("" : "+v"(tid));
    float* fk = (float*)(shm + attn_body::LDS_FK); float* s0 = fk + SEQ; float* s1 = s0 + 512;
    const int t0 = tid * 8;
    f32x4 a = (f32x4){0.f, 0.f, 0.f, 0.f}, b = a;
    if (t0 < n) { a = *(const f32x4*)(LSbh + t0); b = *(const f32x4*)(LSbh + t0 + 4); }
    a.y += a.x; a.z += a.y; a.w += a.z; b.x += a.w; b.y += b.x; b.z += b.y; b.w += b.z;
    const float run = b.w;
    s0[tid] = run;
    __syncthreads();
    float* src = s0; float* dst = s1;
    for (int off = 1; off < 512; off <<= 1) {
        float t = src[tid]; if (tid >= off) t += src[tid - off];
        dst[tid] = t;
        __syncthreads();
        float* tmp = src; src = dst; dst = tmp;
    }
    const float excl = src[tid] - run;
    if (t0 < n) { *(f32x4*)(fk + t0) = a + excl; *(f32x4*)(fk + t0 + 4) = b + excl; }
    __syncthreads();
}

__device__ __forceinline__ void lru_item(int item, int layer, const Params& p, unsigned char* ldsb) {
    unsigned char* ws = p.ws;
    int tid = threadIdx.x; asm volatile("" : "+v"(tid)); const int lane = tid & 63, wave = tid >> 6;
    const int b = item >> 7, c = item & 127, t0 = c * 32; const size_t r0 = (size_t)b * SEQ + t0;
    const bf16_t* XLRU = (const bf16_t*)(ws + WS_XLRU);
    const bf16_t* GLRU = (const bf16_t*)(ws + WS_GLRU);
    const bf16_t* WAT = (const bf16_t*)(ws + WS_WAT);
    float* AGG = (float*)(ws + WS_AGG) + (size_t)layer * (4 * 128 * 2 * 256);
    unsigned* flags = (unsigned*)(ws + WS_FLAGS) + layer * 512;
    bf16_t* Y = (bf16_t*)(ws + WS_Y);
    bf16_t* xcb = (bf16_t*)ldsb;
    float* aL = (float*)(ldsb + 32 * 264 * 2);
    float* bL = aL + 32 * 256;
    float* ex = bL + 32 * 256;
    float* fold = ex + 4 * 256;
    {
        const int ch = (tid & 127) * 2, tq = tid >> 7;
        float w0[4], w1[4];
#pragma unroll
        for (int k = 0; k < 4; ++k) { w0[k] = p.conv_w[(layer * 4 + k) * 256 + ch]; w1[k] = p.conv_w[(layer * 4 + k) * 256 + ch + 1]; }
        const float cb0 = p.conv_b[layer * 256 + ch], cb1 = p.conv_b[layer * 256 + ch + 1];
        float xa[11], xb[11];
#pragma unroll
        for (int i = 0; i < 11; ++i) {
            const int t = t0 + tq * 8 - 3 + i;
            unsigned w = 0u;
            if (t >= 0) w = *(const unsigned*)(XLRU + ((size_t)b * SEQ + t) * 256 + ch);
            xa[i] = bflo(w); xb[i] = bfhi(w);
        }
#pragma unroll
        for (int i = 0; i < 8; ++i) {
            const float y0 = cb0 + w0[0] * xa[i] + w0[1] * xa[i + 1] + w0[2] * xa[i + 2] + w0[3] * xa[i + 3];
            const float y1 = cb1 + w1[0] * xb[i] + w1[1] * xb[i + 1] + w1[2] * xb[i + 2] + w1[3] * xb[i + 3];
            *(unsigned*)(xcb + (tq * 8 + i) * 264 + ch) = pk2(y0, y1);
        }
    }
    __syncthreads();
    {
        const int g = wave >> 1, jh = wave & 1, l31 = lane & 31, hi = lane >> 5;
        const int j = jh * 32 + l31, ch = g * 64 + j;
        f32x16 accR = {}, accI = {};
#pragma unroll
        for (int kb = 0; kb < 4; ++kb) {
            const bf16x8 af = *(const bf16x8*)(xcb + l31 * 264 + g * 64 + kb * 16 + hi * 8);
            const bf16x8 br = *(const bf16x8*)(WAT + ((size_t)((layer * 2 + 0) * 4 + g) * 64 + j) * 64 + kb * 16 + hi * 8);
            const bf16x8 bi = *(const bf16x8*)(WAT + ((size_t)((layer * 2 + 1) * 4 + g) * 64 + j) * 64 + kb * 16 + hi * 8);
            accR = __builtin_amdgcn_mfma_f32_32x32x16_bf16(af, br, accR, 0, 0, 0);
            accI = __builtin_amdgcn_mfma_f32_32x32x16_bf16(af, bi, accI, 0, 0, 0);
        }
        const float ba = p.lru_ba[layer * 256 + ch], bx = p.lru_bx[layer * 256 + ch], lam = p.lru_lambda[layer * 256 + ch];
        const float sp = fmaxf(-lam, 0.f) + log1pf(__expf(-fabsf(lam)));
#pragma unroll
        for (int r = 0; r < 16; ++r) {
            const int t = crow(r, hi);
            const float rg = sigmoid_f(accR[r] + ba), ig = sigmoid_f(accI[r] + bx);
            const float a = __expf(-8.0f * rg * sp);
            const float xc = bf2f(xcb[t * 264 + ch]);
            const float bt = __builtin_amdgcn_sqrtf(fmaxf(1.f - a * a, 0.f)) * (ig * xc);
            aL[t * 256 + ch] = a; bL[t * 256 + ch] = bt;
            if ((r & 3) == 3) asm volatile("" ::: "memory");
        }
    }
    __syncthreads();
    {
        const int ch = tid & 255, half = tid >> 8;
        float hl[16], ca[16]; float hloc = 0.f, cum = 1.f;
#pragma unroll
        for (int i = 0; i < 16; ++i) { const int t = half * 16 + i; const float a = aL[t * 256 + ch], bt = bL[t * 256 + ch]; hloc = a * hloc + bt; cum *= a; hl[i] = hloc; ca[i] = cum; }
        ex[(half * 2 + 0) * 256 + ch] = cum; ex[(half * 2 + 1) * 256 + ch] = hloc;
        __syncthreads();
        if (half == 0) {
            const float A1 = ex[(2 + 0) * 256 + ch], H1 = ex[(2 + 1) * 256 + ch];
            __hip_atomic_store(AGG + ((size_t)(b * 128 + c) * 2 + 0) * 256 + ch, cum * A1, __ATOMIC_RELAXED, __HIP_MEMORY_SCOPE_AGENT);
            __hip_atomic_store(AGG + ((size_t)(b * 128 + c) * 2 + 1) * 256 + ch, A1 * hloc + H1, __ATOMIC_RELAXED, __HIP_MEMORY_SCOPE_AGENT);
        }
        asm volatile("s_waitcnt vmcnt(0)" ::: "memory");
        __syncthreads();
        if (tid == 0) __hip_atomic_store(flags + item, 1u, __ATOMIC_RELAXED, __HIP_MEMORY_SCOPE_AGENT);
        if (tid < c) {
            unsigned* f = flags + (item - c) + tid; unsigned sp = 0u;
            while (__hip_atomic_load(f, __ATOMIC_RELAXED, __HIP_MEMORY_SCOPE_AGENT) == 0u) { __builtin_amdgcn_s_sleep(2); if (++sp > (1u << 22)) break; }
        }
        __syncthreads();
        if (tid == 0) { __builtin_amdgcn_fence(__ATOMIC_ACQUIRE, "agent"); asm volatile("s_waitcnt vmcnt(0)" ::: "memory"); }
        __syncthreads();
        {
            const int q4 = (tid & 63) * 4, seg = tid >> 6, per = (c + 7) >> 3, lo = seg * per, hi2 = (lo + per < c) ? lo + per : c;
            f32x4 Ac = (f32x4){1.f, 1.f, 1.f, 1.f}, Hc = (f32x4){0.f, 0.f, 0.f, 0.f};
#pragma unroll 8
            for (int cc = lo; cc < hi2; ++cc) {
                const f32x4 a4 = *(const f32x4*)(AGG + ((size_t)(b * 128 + cc) * 2 + 0) * 256 + q4), h4 = *(const f32x4*)(AGG + ((size_t)(b * 128 + cc) * 2 + 1) * 256 + q4);
                Hc = a4 * Hc + h4; Ac = Ac * a4;
            }
            *(f32x4*)(fold + (seg * 2 + 0) * 256 + q4) = Ac; *(f32x4*)(fold + (seg * 2 + 1) * 256 + q4) = Hc;
        }
        __syncthreads();
        float carry = 0.f;
#pragma unroll
        for (int sgm = 0; sgm < 8; ++sgm) carry = fold[(sgm * 2 + 0) * 256 + ch] * carry + fold[(sgm * 2 + 1) * 256 + ch];
        if (half == 1) carry = ex[0 * 256 + ch] * carry + ex[1 * 256 + ch];
#pragma unroll
        for (int i = 0; i < 16; ++i) {
            const int t = half * 16 + i; const size_t row = r0 + t;
            const float hv = hl[i] + ca[i] * carry;
            const float gs = bf2f(GLRU[row * 256 + ch]);
            Y[row * 1024 + 512 + ch] = (bf16_t)f2bf(hv * gs);
        }
    }
    __syncthreads();
}

__device__ __forceinline__ void sg_item(int item, int layer, const Params& p, unsigned char* ldsb) {
    unsigned char* ws = p.ws;
    int tid = threadIdx.x; asm volatile("" : "+v"(tid)); const int lane = tid & 63, wave = __builtin_amdgcn_readfirstlane(tid >> 6);
    const int g = item & 3; const size_t r0 = (size_t)(item >> 2) * 128;
    const bf16_t* SGU = (const bf16_t*)(ws + WS_SGU);
    const bf16_t* SGV = (const bf16_t*)(ws + WS_SGV);
    const bf16_t* GSG = (const bf16_t*)(ws + WS_GSG);
    const bf16_t* SGW = (const bf16_t*)(ws + WS_SGW);
    bf16_t* Y = (bf16_t*)(ws + WS_Y);
    bf16_t* vn = (bf16_t*)ldsb;
    const int tt = wave >> 1, dh = wave & 1, l31 = lane & 31, hi = lane >> 5;
    const int nkb = 2 * tt + 2;
    const bf16_t* Wg = SGW + (size_t)(layer * 4 + g) * 128 * 128;
    bf16x8 af[8];
#pragma unroll
    for (int kb = 0; kb < 8; ++kb) af[kb] = (kb < nkb) ? *(const bf16x8*)(Wg + (size_t)(tt * 32 + l31) * 128 + kb * 16 + hi * 8) : (bf16x8){0, 0, 0, 0, 0, 0, 0, 0};
    {
        const int t = wave * 16 + (lane >> 2), qu = lane & 3;
        const uint4* src = (const uint4*)(SGV + (r0 + t) * 256 + qu * 64);
        uint4 w[8];
#pragma unroll
        for (int i = 0; i < 8; ++i) w[i] = src[i];
        float s1 = 0.f, s2 = 0.f;
#pragma unroll
        for (int i = 0; i < 8; ++i) {
            const float x0 = bflo(w[i].x), x1 = bfhi(w[i].x), x2 = bflo(w[i].y), x3 = bfhi(w[i].y), x4 = bflo(w[i].z), x5 = bfhi(w[i].z), x6 = bflo(w[i].w), x7 = bfhi(w[i].w);
            s1 += ((x0 + x1) + (x2 + x3)) + ((x4 + x5) + (x6 + x7));
            s2 += ((x0 * x0 + x1 * x1) + (x2 * x2 + x3 * x3)) + ((x4 * x4 + x5 * x5) + (x6 * x6 + x7 * x7));
        }
        s1 += __shfl_xor(s1, 1); s2 += __shfl_xor(s2, 1); s1 += __shfl_xor(s1, 2); s2 += __shfl_xor(s2, 2);
        const float mu = s1 * (1.f / 256.f);
        const float rs = rsqrtf(fmaxf(s2 * (1.f / 256.f) - mu * mu, 0.f) + EPS);
        if (qu == g) {
            const float* lg = p.sg_ln_g + layer * 256 + g * 64; const float* lb = p.sg_ln_b + layer * 256 + g * 64;
#pragma unroll
            for (int i = 0; i < 8; ++i) {
                const f32x4 g0 = *(const f32x4*)(lg + i * 8), g1 = *(const f32x4*)(lg + i * 8 + 4), b0 = *(const f32x4*)(lb + i * 8), b1 = *(const f32x4*)(lb + i * 8 + 4);
                uint4 o;
                o.x = pk2((bflo(w[i].x) - mu) * rs * g0.x + b0.x, (bfhi(w[i].x) - mu) * rs * g0.y + b0.y);
                o.y = pk2((bflo(w[i].y) - mu) * rs * g0.z + b0.z, (bfhi(w[i].y) - mu) * rs * g0.w + b0.w);
                o.z = pk2((bflo(w[i].z) - mu) * rs * g1.x + b1.x, (bfhi(w[i].z) - mu) * rs * g1.y + b1.y);
                o.w = pk2((bflo(w[i].w) - mu) * rs * g1.z + b1.z, (bfhi(w[i].w) - mu) * rs * g1.w + b1.w);
                *(uint4*)(vn + t * 72 + i * 8) = o;
            }
        }
    }
    __syncthreads();
    {
        const int d = dh * 32 + l31, ch = g * 64 + d;
        float uu[16], gg[16], sb[16];
#pragma unroll
        for (int r = 0; r < 16; ++r) {
            const int t = tt * 32 + crow(r, hi); const size_t row = r0 + t;
            uu[r] = bf2f(SGU[row * 256 + ch]); gg[r] = bf2f(GSG[row * 256 + ch]); sb[r] = p.sg_b[(layer * 4 + g) * 128 + t];
        }
        f32x16 acc = (f32x16){};
#pragma unroll
        for (int kb = 0; kb < 8; ++kb) {
            if (kb < nkb) {
                bf16x8 bfr;
#pragma unroll
                for (int i = 0; i < 8; ++i) bfr[i] = (short)vn[(kb * 16 + hi * 8 + i) * 72 + d];
                acc = __builtin_amdgcn_mfma_f32_32x32x16_bf16(af[kb], bfr, acc, 0, 0, 0);
            }
        }
#pragma unroll
        for (int r = 0; r < 16; ++r) {
            const int t = tt * 32 + crow(r, hi); const size_t row = r0 + t;
            Y[row * 1024 + 768 + ch] = (bf16_t)f2bf(uu[r] * (acc[r] + sb[r]) * gg[r]);
        }
    }
    __syncthreads();
}

#define LAS __attribute__((address_space(3)))
#define XB_TMO      128
#define XB_XCNT(j)  (256  + 64 * (j))
#define XB_XSUB(j)  (1280 + 64 * (j))
#define XB_XGEN(j)  (2304 + 64 * (j))
#define XB_TOP      3328
#define XB_TOPGEN   3392
#define XCD_BAR_WORDS 3456
#define XB_SPIN_CAP (1u << 18)

__device__ __forceinline__ unsigned xb_ld(unsigned* p)              { return __hip_atomic_load(p, __ATOMIC_RELAXED, __HIP_MEMORY_SCOPE_AGENT); }
__device__ __forceinline__ unsigned xb_add(unsigned* p, unsigned v) { return __hip_atomic_fetch_add(p, v, __ATOMIC_RELAXED, __HIP_MEMORY_SCOPE_AGENT); }
__device__ __forceinline__ unsigned xb_xcc_id() { return (unsigned)__builtin_amdgcn_s_getreg((3 << 11) | 20) & 0xFu; }
#define XB_SPIN(cond, bar) do { unsigned _sp = 0; while (cond) { __builtin_amdgcn_s_sleep(1); \
    if ((++_sp & 255u) == 0u) { if (xb_ld(&(bar)[XB_TMO])) break; if (_sp > XB_SPIN_CAP) { atomicAdd(&(bar)[XB_TMO], 1u); break; } } } } while (0)

struct XcdBarrier {
    unsigned* bar; unsigned x;
    volatile LAS unsigned* st;
};

__device__ __forceinline__ XcdBarrier xcd_barrier_post(unsigned* bar, volatile LAS unsigned* st) {
    XcdBarrier b; b.bar = bar; b.x = xb_xcc_id(); b.st = st;
    if (threadIdx.x == 0) (void)xb_add(&bar[XB_XCNT(b.x)], 1u);
    return b;
}
__device__ __forceinline__ void xcd_barrier_complete(unsigned* bar, unsigned x, unsigned& nloc, unsigned& nx) {
    const unsigned G = gridDim.x * gridDim.y * gridDim.z;
    unsigned sum, cnt, mine, sp = 0u;
    for (;;) {
        sum = 0u; cnt = 0u; mine = 0u;
#pragma unroll
        for (unsigned j = 0; j < 16; ++j) { const unsigned c = xb_ld(&bar[XB_XCNT(j)]); sum += c; cnt += (c > 0u) ? 1u : 0u; mine = (j == x) ? c : mine; }
        if (sum == G) break;
        __builtin_amdgcn_s_sleep(1);
        if ((++sp & 255u) == 0u) { if (xb_ld(&bar[XB_TMO])) break; if (sp > XB_SPIN_CAP) { atomicAdd(&bar[XB_TMO], 1u); break; } }
    }
    nloc = mine > 0u ? mine : 1u; nx = cnt > 0u ? cnt : 1u;
}

__device__ __forceinline__ void xcd_barrier(const XcdBarrier& b) {
    asm volatile("s_waitcnt vmcnt(0)" ::: "memory");
    __syncthreads();
    if (threadIdx.x == 0) {
        unsigned* bar = b.bar;
        __builtin_amdgcn_s_waitcnt(0);
        unsigned nloc = b.st[0], nx = b.st[1];
        if (nloc == 0u) { xcd_barrier_complete(bar, b.x, nloc, nx); b.st[0] = nloc; b.st[1] = nx; }
        const unsigned old = xb_add(&bar[XB_XSUB(b.x)], 1u);
        const unsigned gen = old / nloc;
        if (old + 1u == (gen + 1u) * nloc) {
            __builtin_amdgcn_fence(__ATOMIC_RELEASE, "agent");
            asm volatile("s_waitcnt vmcnt(0)" ::: "memory");
            const unsigned og = xb_add(&bar[XB_TOP], 1u);
            const unsigned tg = og / nx;
            if (og + 1u == (tg + 1u) * nx) xb_add(&bar[XB_TOPGEN], 1u);
            else XB_SPIN(xb_ld(&bar[XB_TOPGEN]) == tg, bar);
            __builtin_amdgcn_fence(__ATOMIC_ACQUIRE, "agent");
            xb_add(&bar[XB_XGEN(b.x)], 1u);
            asm volatile("s_waitcnt vmcnt(0)" ::: "memory");
        } else {
            XB_SPIN(xb_ld(&bar[XB_XGEN(b.x)]) == gen, bar);
            __builtin_amdgcn_fence(__ATOMIC_ACQUIRE, "agent");
            asm volatile("s_waitcnt vmcnt(0)" ::: "memory");
        }
    }
    __syncthreads();
}

__global__ void __launch_bounds__(NTHREADS) fwd_megakernel(Params p) {
    extern __shared__ __attribute__((aligned(16))) unsigned char lds[];
    cg::grid_group grid = cg::this_grid();
    unsigned char* ws = p.ws;
    const int G = gridDim.x, blk = blockIdx.x;
    ProjOut PO{(bf16_t*)(ws + WS_Q), (bf16_t*)(ws + WS_K), (bf16_t*)(ws + WS_V), (bf16_t*)(ws + WS_GATT), (bf16_t*)(ws + WS_XLRU), (bf16_t*)(ws + WS_GLRU),
               (bf16_t*)(ws + WS_SGU), (bf16_t*)(ws + WS_SGV), (bf16_t*)(ws + WS_GSG)};

    if (threadIdx.x < 8) ((LAS unsigned*)(lds + BARST_OFF))[threadIdx.x] = 0u;
    __syncthreads();
    const XcdBarrier xbar = xcd_barrier_post((unsigned*)(ws + WS_BAR), (volatile LAS unsigned*)(lds + BARST_OFF));
    p0_prologue(p, (float*)lds);
    if (p.ws == nullptr) grid.sync();
    xcd_barrier(xbar);
    row_pass<true, true>(p, 0, 0, p.x, nullptr, (float*)lds);
    xcd_barrier(xbar);
    for (int layer = 0; layer < NLAYER; ++layer) {
        { pg8::Gemm g{(const bf16_t*)(ws + WS_H), (const bf16_t*)(ws + WS_WINT + layer * WS_WINT_STRIDE), MROWS, NPROJ_PAD, DM}; pg8::StaticOrder S; S.init(MROWS, NPROJ_PAD, G, blk);
          pg8::EpiProj E{PO, p.b_f + layer * 8, (float*)(ws + WS_LS)};
          pg8::gemm_phase<pg8::EpiProj, pg8::StaticOrder, true, true>((PG8_LAS unsigned char*)lds, g, S, E); }
        xcd_barrier(xbar);
        for (int it = blk; it < 512; it += G) lru_item(it, layer, p, lds);
        for (int it = blk; it < 512; it += G) sg_item(it, layer, p, lds);
        { const int vcu = (G % 8 == 0) ? (blk % 8) * (G / 8) + blk / 8 : blk;
          static_assert(attn_body::ATTN_LDS_BYTES <= 131072, "attention LDS");
          for (int v = vcu; v < 256; v += G) { const int bh = v >> 3, s = v & 7;
            fk_cumsum((const float*)(ws + WS_LS) + (size_t)bh * SEQ, (16 - s) * 256, lds);
            for (int i = 0; i < 2; ++i) attn_body::attn_unit<8, false>(bh >> 3, bh & 7, i == 0 ? 15 - s : s, (const attn_body::bf16*)(ws + WS_Q), (const attn_body::bf16*)(ws + WS_K), (const attn_body::bf16*)(ws + WS_V),
                (attn_body::bf16*)(ws + WS_Y), (const attn_body::bf16*)(ws + WS_GATT), nullptr, (char*)lds); }
          __syncthreads(); }
        xcd_barrier(xbar);
        { pg8::Gemm g{(const bf16_t*)(ws + WS_Y), (const bf16_t*)(ws + WS_WOUTT + (size_t)layer * 2 * MiB), MROWS, DM, DM}; pg8::StaticOrder S; S.init(MROWS, DM, G, blk);
          pg8::EpiBf16<0> E{(bf16_t*)(ws + WS_YOUT), DM, nullptr, 0, 0, 1.f};
          pg8::gemm_phase<pg8::EpiBf16<0>, pg8::StaticOrder, true, true>((PG8_LAS unsigned char*)lds, g, S, E); }
        xcd_barrier(xbar);
        if (layer == 0) { row_pass<false, true>(p, 0, 1, p.x, p.out, (float*)lds); xcd_barrier(xbar); }
        else row_pass<false, false>(p, 1, 1, p.out, p.out, (float*)lds);
    }
}

extern "C" void kernel_launch(void* const* d_in, const int* in_sizes, int n_in, void* d_out, int out_size, void* d_ws, size_t ws_size, hipStream_t stream) {
    static int grid = 0;
    if (grid == 0) {
        if (n_in != 20 || out_size != MROWS * DM || ws_size < WS_END) { fprintf(stderr, "kernel_launch: unexpected shapes (n_in %d out %d ws %zu)\n", n_in, out_size, ws_size); grid = -1; return; }
        int dev = 0, cus = 0, per_cu = 0;
        if (hipGetDevice(&dev) != hipSuccess || hipDeviceGetAttribute(&cus, hipDeviceAttributeMultiprocessorCount, dev) != hipSuccess) { grid = -1; return; }
        if (hipFuncSetAttribute((const void*)fwd_megakernel, hipFuncAttributeMaxDynamicSharedMemorySize, LDS_BYTES) != hipSuccess) { fprintf(stderr, "kernel_launch: hipFuncSetAttribute failed\n"); grid = -1; return; }
        if (hipOccupancyMaxActiveBlocksPerMultiprocessor(&per_cu, (const void*)fwd_megakernel, NTHREADS, LDS_BYTES) != hipSuccess || per_cu < 1) { fprintf(stderr, "kernel_launch: occupancy query says %d\n", per_cu); per_cu = 1; }
        (void)hipGetLastError();
        grid = cus;
    }
    if (grid < 0) return;
    if (hipMemsetAsync(d_ws, 0, 65536, stream) != hipSuccess) { fprintf(stderr, "kernel_launch: memset failed\n"); return; }
    Params p{};
    p.x = (const float*)d_in[0]; p.c = (const float*)d_in[1]; p.ada_w = (const float*)d_in[2]; p.ada_b = (const float*)d_in[3]; p.pre_g = (const float*)d_in[4];
    p.post_g = (const float*)d_in[5]; p.w_in = (const float*)d_in[6]; p.b_f = (const float*)d_in[7]; p.conv_w = (const float*)d_in[8]; p.conv_b = (const float*)d_in[9];
    p.lru_wa = (const float*)d_in[10]; p.lru_ba = (const float*)d_in[11]; p.lru_wx = (const float*)d_in[12]; p.lru_bx = (const float*)d_in[13]; p.lru_lambda = (const float*)d_in[14];
    p.sg_ln_g = (const float*)d_in[15]; p.sg_ln_b = (const float*)d_in[16]; p.sg_w = (const float*)d_in[17]; p.sg_b = (const float*)d_in[18]; p.w_out = (const float*)d_in[19];
    p.out = (float*)d_out; p.ws = (unsigned char*)d_ws;
    void* args[] = {&p};
    hipError_t e = hipLaunchCooperativeKernel((const void*)fwd_megakernel, dim3(grid), dim3(NTHREADS), args, LDS_BYTES, stream);
    if (e != hipSuccess) fprintf(stderr, "kernel_launch: cooperative launch failed: %s (grid %d)\n", hipGetErrorString(e), grid);
}
```
